# Optimizing an MI355X kernel written in HIP

```python
import math
import jax
import jax.numpy as jnp
from jax import lax
import numpy as np

D_MODEL = 1024
BATCH = 8
SEQ = 2048
DEPTH = 4
DEC_BATCH = 128
DEC_SEQ = 4
PAST_LEN = 16384
PAGE_SIZE = 128

N_MIXERS = 3
N_A = (DEPTH + 2) // 3
N_B = (DEPTH + 1) // 3
N_C = DEPTH // 3

D_FF = -(-8 * D_MODEL // (3 * 256)) * 256
NORM_EPS = 1e-6

HG_EXPAND = 128
HG_HEADS = D_MODEL // HG_EXPAND
HG_DK = HG_EXPAND
HG_DV = D_MODEL // HG_HEADS
HG_CHUNK = 64
HG_MIN_F = 1e-30

RW_HEAD = 64
RW_HEADS = D_MODEL // RW_HEAD
RW_DECAY_LORA = 64
RW_A_LORA = 64
RW_GATE_LORA = 128
RW_GN_EPS = 64e-5

MB_EXPAND = 2
MB_DI = MB_EXPAND * D_MODEL
MB_HEADDIM = 64
MB_HEADS = MB_DI // MB_HEADDIM
MB_GROUPS = 4
MB_DSTATE = 128
MB_CONV = 4
MB_CONV_DIM = MB_DI + 2 * MB_GROUPS * MB_DSTATE
MB_IN = 2 * MB_DI + 2 * MB_GROUPS * MB_DSTATE + MB_HEADS
MB_CHUNK = 128

kernel_name = 'hybrid_hgrn2_rwkv7_mamba2_decode_step'

F32 = jnp.float32


def _rmsnorm(x, g, eps=NORM_EPS):
    xf = x.astype(F32)
    y = xf * lax.rsqrt(jnp.mean(xf * xf, axis=-1, keepdims=True) + eps)
    return (y * g.astype(F32)).astype(x.dtype)


def _swiglu(h, w_gate, w_up, w_down):
    return (jax.nn.silu(h @ w_gate) * (h @ w_up)) @ w_down


def _to_chunks(a, c):
    b, t = a.shape[0], a.shape[1]
    return jnp.moveaxis(a.reshape((b, t // c, c) + a.shape[2:]), 1, 0)


def _from_chunks(a):
    a = jnp.moveaxis(a, 0, 1)
    return a.reshape((a.shape[0], a.shape[1] * a.shape[2]) + a.shape[3:])


def _masked_exp(tri, diff):
    return jnp.where(tri, jnp.exp(jnp.where(tri, diff, 0.0)), 0.0)


def _gla_chunk_scan(q, k, v, log_f, s0, c):
    tri = jnp.tril(jnp.ones((c, c), dtype=bool))[None, :, :, None, None]

    def step(s, inp):
        qc, kc, vc, lfc = inp
        g = jnp.cumsum(lfc, axis=1)
        o_inter = jnp.einsum('bihk,bhkv->bihv', qc * jnp.exp(g), s)
        decay = _masked_exp(tri, g[:, :, None] - g[:, None, :])
        att = jnp.einsum('bihk,bjhk,bijhk->bhij', qc, kc, decay)
        o_intra = jnp.einsum('bhij,bjhv->bihv', att, vc)
        g_last = g[:, -1]
        k_dec = kc * jnp.exp(g_last[:, None] - g)
        s_new = jnp.exp(g_last)[..., None] * s + jnp.einsum('bjhk,bjhv->bhkv', k_dec, vc)
        return s_new, o_inter + o_intra

    s, o = lax.scan(step, s0, (_to_chunks(q, c), _to_chunks(k, c), _to_chunks(v, c), _to_chunks(log_f, c)))
    return _from_chunks(o), s


def _hgrn2(h, s0, w_in, lb_logits, j, norm_g, w_out):
    b, t, _ = h.shape
    proj = (h @ w_in).astype(F32)
    q_r, f_r, i_r, g_r = jnp.split(proj, 4, axis=-1)
    sm = jax.nn.softmax(lb_logits.astype(F32), axis=0)
    lb = (jnp.cumsum(sm, axis=0) - sm[0])[j]
    f = lb + (1.0 - lb) * jax.nn.sigmoid(f_r)
    log_f = jnp.log(jnp.maximum(f, HG_MIN_F))
    k = (1.0 - lb) * jax.nn.sigmoid(-f_r)
    q = jax.nn.silu(q_r)
    hd = lambda a: a.reshape(b, t, HG_HEADS, -1)
    c = math.gcd(t, HG_CHUNK)
    o, s = _gla_chunk_scan(hd(q), hd(k), hd(i_r), hd(log_f), s0.astype(F32), c)
    o = _rmsnorm(o, norm_g) * jax.nn.silu(hd(g_r))
    y = o.reshape(b, t, D_MODEL).astype(h.dtype) @ w_out
    return y, s.astype(s0.dtype)


def _rwkv7(h, s0, shift0, mu, w_rkv, w0, w1, w2, a0, a1, a2, g1, g2, k_k, k_a, r_k,
           lnx_w, lnx_b, w_out):
    b, t, d = h.shape
    hf = h.astype(F32)
    prev = jnp.concatenate([shift0[:, None].astype(F32), hf[:, :-1]], axis=1)
    xx = prev - hf
    xs = hf[None] + xx[None] * mu[:, None, None, :].astype(F32)
    rkv = jnp.einsum('nbtd,nde->nbte', xs[:3], w_rkv)
    r, k, v = rkv[0], rkv[1], rkv[2]
    w_log = -jax.nn.softplus(-(w0 + jnp.tanh(xs[3] @ w1) @ w2)) - 0.5
    decay = jnp.exp(-jnp.exp(w_log))
    a = jax.nn.sigmoid(a0 + (xs[4] @ a1) @ a2)
    gate = jax.nn.sigmoid(xs[5] @ g1) @ g2
    hd = lambda z: z.reshape(b, t, RW_HEADS, RW_HEAD)
    kk = hd(k * k_k)
    kk = kk * lax.rsqrt(jnp.maximum(jnp.sum(kk * kk, axis=-1, keepdims=True), 1e-24))
    k = k * (1.0 + (a - 1.0) * k_a)
    r, k, v, decay, a = hd(r), hd(k), hd(v), hd(decay), hd(a)

    def step(s, inp):
        r_t, w_t, k_t, v_t, kk_t, a_t = inp
        sa = jnp.einsum('bhvk,bhk->bhv', s, -kk_t)
        s = (s * w_t[:, :, None, :] + sa[..., None] * (kk_t * a_t)[:, :, None, :]
             + v_t[..., None] * k_t[:, :, None, :])
        return s, jnp.einsum('bhvk,bhk->bhv', s, r_t)

    tm = lambda z: jnp.moveaxis(z, 1, 0)
    s, o = lax.scan(step, s0.astype(F32), (tm(r), tm(decay), tm(k), tm(v), tm(kk), tm(a)))
    o = jnp.moveaxis(o, 0, 1)
    mean = jnp.mean(o, axis=-1, keepdims=True)
    var = jnp.mean(jnp.square(o - mean), axis=-1, keepdims=True)
    o = ((o - mean) * lax.rsqrt(var + RW_GN_EPS)).reshape(b, t, d) * lnx_w + lnx_b
    bonus = jnp.sum(r * k * r_k, axis=-1, keepdims=True) * v
    o = (o + bonus.reshape(b, t, d)) * gate
    y = o.astype(h.dtype) @ w_out
    return y, s.astype(s0.dtype), hf[:, -1].astype(shift0.dtype)


def _ssd_chunk_scan(x, bm, cm, dt, da, s0, c):
    tri = jnp.tril(jnp.ones((c, c), dtype=bool))[None, :, :, None, None]

    def step(s, inp):
        xc, bc, cc, dtc, dac = inp
        cum = jnp.cumsum(dac, axis=1)
        seg = _masked_exp(tri, cum[:, :, None] - cum[:, None, :])
        cb = jnp.einsum('bign,bjgn->bijg', cc, bc)
        m = cb[..., None] * seg * dtc[:, None]
        y_intra = jnp.einsum('bijgh,bjghp->bighp', m, xc)
        y_inter = jnp.einsum('bign,bghpn->bighp', cc, s) * jnp.exp(cum)[..., None]
        last = cum[:, -1]
        wts = dtc * jnp.exp(last[:, None] - cum)
        s_new = jnp.exp(last)[..., None, None] * s + jnp.einsum('bjgn,bjgh,bjghp->bghpn', bc, wts, xc)
        return s_new, y_intra + y_inter

    s, y = lax.scan(step, s0, (_to_chunks(x, c), _to_chunks(bm, c), _to_chunks(cm, c),
                               _to_chunks(dt, c), _to_chunks(da, c)))
    return _from_chunks(y), s


def _mamba2(h, s0, conv0, w_in, conv_w, conv_b, dt_bias, a_log, d_skip, norm_g, w_out):
    b, t, _ = h.shape
    ng, hg, pd, ns = MB_GROUPS, MB_HEADS // MB_GROUPS, MB_HEADDIM, MB_DSTATE
    zxbcdt = (h @ w_in).astype(F32)
    z = zxbcdt[..., :MB_DI]
    xbc = zxbcdt[..., MB_DI:MB_DI + MB_CONV_DIM]
    dt_r = zxbcdt[..., MB_DI + MB_CONV_DIM:]
    xpad = jnp.concatenate([conv0.astype(F32), xbc], axis=1)
    conv = conv_b.astype(F32)
    for w in range(MB_CONV):
        conv = conv + xpad[:, w:w + t] * conv_w[w]
    xbc = jax.nn.silu(conv)
    xs = xbc[..., :MB_DI].reshape(b, t, ng, hg, pd)
    bm = xbc[..., MB_DI:MB_DI + ng * ns].reshape(b, t, ng, ns)
    cm = xbc[..., MB_DI + ng * ns:].reshape(b, t, ng, ns)
    dt = jax.nn.softplus(dt_r + dt_bias).reshape(b, t, ng, hg)
    da = dt * (-jnp.exp(a_log.astype(F32))).reshape(ng, hg)
    c = math.gcd(t, MB_CHUNK)
    y, s = _ssd_chunk_scan(xs, bm, cm, dt, da, s0.astype(F32).reshape(b, ng, hg, pd, ns), c)
    y = y + d_skip.reshape(ng, hg)[:, :, None] * xs
    y = y.reshape(b, t, MB_DI) * jax.nn.silu(z)
    yg = y.reshape(b, t, ng, -1)
    yg = yg * lax.rsqrt(jnp.mean(yg * yg, axis=-1, keepdims=True) + NORM_EPS)
    y = yg.reshape(b, t, MB_DI) * norm_g
    out = y.astype(h.dtype) @ w_out
    return (out, s.reshape(b, MB_HEADS, pd, ns).astype(s0.dtype),
            xpad[:, -(MB_CONV - 1):].astype(conv0.dtype))


def _trunk(x, st_hg, st_wkv, st_shift, st_ssm, st_conv, p):
    new_hg, new_wkv, new_shift, new_ssm, new_conv = [], [], [], [], []
    for i in range(DEPTH):
        j = i // N_MIXERS
        h = _rmsnorm(x, p['norm_mix'][i])
        if i % N_MIXERS == 0:
            out, s = _hgrn2(h, st_hg[j], p['hg_w_in'][j], p['hg_lb_logits'], j,
                            p['hg_norm'][j], p['hg_w_out'][j])
            new_hg.append(s)
        elif i % N_MIXERS == 1:
            out, s, sh = _rwkv7(h, st_wkv[j], st_shift[j], p['rw_mu'][j], p['rw_w_rkv'][j],
                                p['rw_w0'][j], p['rw_w1'][j], p['rw_w2'][j],
                                p['rw_a0'][j], p['rw_a1'][j], p['rw_a2'][j],
                                p['rw_g1'][j], p['rw_g2'][j], p['rw_k_k'][j], p['rw_k_a'][j],
                                p['rw_r_k'][j], p['rw_lnx_w'][j], p['rw_lnx_b'][j], p['rw_w_out'][j])
            new_wkv.append(s)
            new_shift.append(sh)
        else:
            out, s, cv = _mamba2(h, st_ssm[j], st_conv[j], p['mb_w_in'][j], p['mb_conv_w'][j],
                                 p['mb_conv_b'][j], p['mb_dt_bias'][j], p['mb_A_log'][j],
                                 p['mb_D'][j], p['mb_norm'][j], p['mb_w_out'][j])
            new_ssm.append(s)
            new_conv.append(cv)
        x = x + out
        x = x + _swiglu(_rmsnorm(x, p['norm_ffn'][i]), p['ffn_w_gate'][i], p['ffn_w_up'][i],
                        p['ffn_w_down'][i])
    y = _rmsnorm(x, p['norm_final'])
    return (y, jnp.stack(new_hg), jnp.stack(new_wkv), jnp.stack(new_shift),
            jnp.stack(new_ssm), jnp.stack(new_conv))


def setup_inputs(seed: int = 0) -> dict:
    key = jax.random.key(seed)
    ks = iter(jax.random.split(key, 64))
    nrm = lambda shape, scale: scale * jax.random.normal(next(ks), shape, F32)
    D = D_MODEL
    inp = {}
    inp['x_prompt'] = nrm((BATCH, SEQ, D), 1.0)
    inp['x_sample'] = nrm((DEC_BATCH, DEC_SEQ, D), 1.0)
    inp['state_hgrn'] = nrm((N_A, DEC_BATCH, HG_HEADS, HG_DK, HG_DV), 0.5)
    inp['state_wkv'] = nrm((N_B, DEC_BATCH, RW_HEADS, RW_HEAD, RW_HEAD), 0.3)
    inp['state_shift'] = nrm((N_B, DEC_BATCH, D), 1.0)
    inp['state_ssm'] = nrm((N_C, DEC_BATCH, MB_HEADS, MB_HEADDIM, MB_DSTATE), 0.3)
    inp['state_conv'] = nrm((N_C, DEC_BATCH, MB_CONV - 1, MB_CONV_DIM), 1.0)
    inp['norm_mix'] = 1.0 + nrm((DEPTH, D), 0.02)
    inp['norm_ffn'] = 1.0 + nrm((DEPTH, D), 0.02)
    inp['norm_final'] = 1.0 + nrm((D,), 0.02)
    inp['ffn_w_gate'] = nrm((DEPTH, D, D_FF), D ** -0.5)
    inp['ffn_w_up'] = nrm((DEPTH, D, D_FF), D ** -0.5)
    inp['ffn_w_down'] = nrm((DEPTH, D_FF, D), D_FF ** -0.5)
    inp['hg_w_in'] = nrm((N_A, D, 4 * D), D ** -0.5)
    inp['hg_lb_logits'] = nrm((N_A, D), 0.5)
    inp['hg_norm'] = 1.0 + nrm((N_A, HG_DV), 0.02)
    inp['hg_w_out'] = nrm((N_A, D, D), D ** -0.5)
    inp['rw_mu'] = jax.random.uniform(next(ks), (N_B, 6, D), F32)
    inp['rw_w_rkv'] = nrm((N_B, 3, D, D), D ** -0.5)
    inp['rw_w0'] = jnp.linspace(-6.0, -1.0, D, dtype=F32)[None] + nrm((N_B, D), 0.1)
    inp['rw_w1'] = nrm((N_B, D, RW_DECAY_LORA), D ** -0.5)
    inp['rw_w2'] = nrm((N_B, RW_DECAY_LORA, D), 0.1 * RW_DECAY_LORA ** -0.5)
    inp['rw_a0'] = nrm((N_B, D), 0.1)
    inp['rw_a1'] = nrm((N_B, D, RW_A_LORA), D ** -0.5)
    inp['rw_a2'] = nrm((N_B, RW_A_LORA, D), 0.1 * RW_A_LORA ** -0.5)
    inp['rw_g1'] = nrm((N_B, D, RW_GATE_LORA), D ** -0.5)
    inp['rw_g2'] = nrm((N_B, RW_GATE_LORA, D), RW_GATE_LORA ** -0.5)
    inp['rw_k_k'] = 0.85 + nrm((N_B, D), 0.02)
    inp['rw_k_a'] = 1.0 + nrm((N_B, D), 0.02)
    inp['rw_r_k'] = nrm((N_B, RW_HEADS, RW_HEAD), 0.1)
    inp['rw_lnx_w'] = 1.0 + nrm((N_B, D), 0.02)
    inp['rw_lnx_b'] = nrm((N_B, D), 0.01)
    inp['rw_w_out'] = nrm((N_B, D, D), D ** -0.5)
    inp['mb_w_in'] = nrm((N_C, D, MB_IN), D ** -0.5)
    inp['mb_conv_w'] = nrm((N_C, MB_CONV, MB_CONV_DIM), 0.5)
    inp['mb_conv_b'] = nrm((N_C, MB_CONV_DIM), 0.01)
    dt0 = jnp.exp(jax.random.uniform(next(ks), (N_C, MB_HEADS), F32,
                                     minval=math.log(1e-3), maxval=math.log(1e-1)))
    inp['mb_dt_bias'] = dt0 + jnp.log(-jnp.expm1(-dt0))
    inp['mb_A_log'] = jnp.log(jax.random.uniform(next(ks), (N_C, MB_HEADS), F32, minval=1.0, maxval=16.0))
    inp['mb_D'] = 1.0 + nrm((N_C, MB_HEADS), 0.1)
    inp['mb_norm'] = 1.0 + nrm((N_C, MB_DI), 0.02)
    inp['mb_w_out'] = nrm((N_C, MB_DI, D), MB_DI ** -0.5)
    return inp


def reference(x_prompt, x_sample, state_hgrn, state_wkv, state_shift, state_ssm, state_conv,
              norm_mix, norm_ffn, norm_final, ffn_w_gate, ffn_w_up, ffn_w_down,
              hg_w_in, hg_lb_logits, hg_norm, hg_w_out,
              rw_mu, rw_w_rkv, rw_w0, rw_w1, rw_w2, rw_a0, rw_a1, rw_a2, rw_g1, rw_g2,
              rw_k_k, rw_k_a, rw_r_k, rw_lnx_w, rw_lnx_b, rw_w_out,
              mb_w_in, mb_conv_w, mb_conv_b, mb_dt_bias, mb_A_log, mb_D, mb_norm, mb_w_out):
    p = dict(norm_mix=norm_mix, norm_ffn=norm_ffn, norm_final=norm_final,
             ffn_w_gate=ffn_w_gate, ffn_w_up=ffn_w_up, ffn_w_down=ffn_w_down,
             hg_w_in=hg_w_in, hg_lb_logits=hg_lb_logits, hg_norm=hg_norm, hg_w_out=hg_w_out,
             rw_mu=rw_mu, rw_w_rkv=rw_w_rkv, rw_w0=rw_w0, rw_w1=rw_w1, rw_w2=rw_w2,
             rw_a0=rw_a0, rw_a1=rw_a1, rw_a2=rw_a2, rw_g1=rw_g1, rw_g2=rw_g2,
             rw_k_k=rw_k_k, rw_k_a=rw_k_a, rw_r_k=rw_r_k, rw_lnx_w=rw_lnx_w,
             rw_lnx_b=rw_lnx_b, rw_w_out=rw_w_out,
             mb_w_in=mb_w_in, mb_conv_w=mb_conv_w, mb_conv_b=mb_conv_b,
             mb_dt_bias=mb_dt_bias, mb_A_log=mb_A_log, mb_D=mb_D, mb_norm=mb_norm,
             mb_w_out=mb_w_out)
    nb = x_prompt.shape[0]
    empty = lambda s: jnp.zeros((s.shape[0], nb) + s.shape[2:], s.dtype)
    y_prompt, hg_p, wkv_p, sh_p, ssm_p, cv_p = _trunk(
        x_prompt, empty(state_hgrn), empty(state_wkv), empty(state_shift),
        empty(state_ssm), empty(state_conv), p)
    y_sample, hg_s, wkv_s, sh_s, ssm_s, cv_s = _trunk(
        x_sample, state_hgrn, state_wkv, state_shift, state_ssm, state_conv, p)
    return (y_prompt, y_sample, hg_p, hg_s, wkv_p, wkv_s, sh_p, sh_s, ssm_p, ssm_s, cv_p, cv_s)
```

```cpp
#include <hip/hip_runtime.h>
#include <hip/hip_cooperative_groups.h>
#include <cstdio>
namespace cg = cooperative_groups;

#define LAS __attribute__((address_space(3)))
typedef unsigned short bf16_t;
typedef short bf16x8 __attribute__((ext_vector_type(8)));
typedef float f32x4 __attribute__((ext_vector_type(4)));
typedef float f32x2 __attribute__((ext_vector_type(2)));
typedef unsigned u32x4 __attribute__((ext_vector_type(4)));
typedef unsigned u32x2 __attribute__((ext_vector_type(2)));

constexpr int NT = 16896, NP = 16384, D = 1024, DFF = 2816;
constexpr float NORM_EPS = 1e-6f;
constexpr size_t O_HGP = 17301504, O_HGS = 19398656, O_WKVP = 52953088, O_WKVS = 53477376, O_SHP = 61865984, O_SHS = 61874176,
                 O_SSMP = 62005248, O_SSMS = 64102400, O_CVP = 97656832, O_CVS = 97730560;
constexpr size_t MiB = 1048576;
constexpr size_t WS_WB = 1 * MiB;
constexpr size_t W_GU = 0, W_GU_SZ = (size_t)5632 * 1024, W_D = W_GU + 4 * W_GU_SZ, W_D_SZ = (size_t)1024 * 2816, W_HGIN = W_D + 4 * W_D_SZ, W_HGIN_SZ = (size_t)4096 * 1024,
                 W_HGOUT = W_HGIN + 2 * W_HGIN_SZ, W_HGOUT_SZ = (size_t)1024 * 1024, W_RWIN = W_HGOUT + 2 * W_HGOUT_SZ, W_RWL2 = W_RWIN + (size_t)3328 * 2048,
                 W_RWOUT = W_RWL2 + (size_t)3072 * 256, W_MBIN = W_RWOUT + (size_t)1024 * 1024, W_MBOUT = W_MBIN + (size_t)5376 * 1024, W_END = W_MBOUT + (size_t)1024 * 2048;
static_assert(W_END * 2 <= 117 * MiB, "weights");
constexpr size_t WS_B0 = 119 * MiB, WS_B1 = WS_B0 + 66 * MiB, WS_B2 = WS_B1 + 99 * MiB, WS_B3 = WS_B2 + 66 * MiB, WS_B4 = WS_B3 + 99 * MiB, WS_END = WS_B4 + 3 * MiB;
constexpr int LDS_BYTES = 147456;

struct Params { const float* in[41]; float* out; unsigned char* ws; };
typedef const Params __attribute__((address_space(4))) * KParams;
__device__ __forceinline__ const Params& getp() { KParams k = (KParams)__builtin_amdgcn_kernarg_segment_ptr(); asm volatile("" : "+s"(k)); return *(const Params*)k; }

__device__ __forceinline__ int tidx() { int t = threadIdx.x; asm volatile("" : "+v"(t)); return t; }
__device__ __forceinline__ unsigned cvt_pk_bf16(float lo, float hi) { unsigned r; asm volatile("v_cvt_pk_bf16_f32 %0, %1, %2" : "=v"(r) : "v"(lo), "v"(hi)); return r; }
__device__ __forceinline__ float bflo(unsigned w) { return __uint_as_float(w << 16); }
__device__ __forceinline__ float bfhi(unsigned w) { return __uint_as_float(w & 0xffff0000u); }
__device__ __forceinline__ float sigmoidf_(float x) { return 1.0f / (1.0f + __expf(-x)); }
__device__ __forceinline__ float siluf_(float x) { return x * sigmoidf_(x); }
__device__ __forceinline__ float softplusf_(float x) { return fmaxf(x, 0.f) + log1pf(__expf(-fabsf(x))); }
template <int CTRL> __device__ __forceinline__ float dppf(float x) { return __int_as_float(__builtin_amdgcn_update_dpp(0, __float_as_int(x), CTRL, 0xf, 0xf, true)); }
__device__ __forceinline__ float red4(float x) { x += dppf<0xB1>(x); x += dppf<0x4E>(x); return x; }
__device__ __forceinline__ float red8(float x) { x = red4(x); x += dppf<0x141>(x); return x; }
__device__ __forceinline__ float red16(float x) { x = red8(x); x += dppf<0x140>(x); return x; }
__device__ __forceinline__ float red64(float x) { x = red16(x); x += __shfl_xor(x, 16); x += __shfl_xor(x, 32); return x; }
__device__ __forceinline__ f32x4 ld4(const float* p) { return *(const f32x4*)p; }

namespace pg8 {
constexpr int BM = 256, BK = 64, HALF = 128, HTB = HALF * BK * 2, NXCD = 8, WGM = 8;
__device__ __forceinline__ int lds_byte(int r, int c) { const int st = (r >> 4) * 2 + (c >> 5), rr = r & 15, cc = c & 31, ob = rr * 64 + cc * 2; return st * 1024 + (ob ^ (((ob >> 9) & 1) << 5)); }
__device__ __forceinline__ void stage_rc(int b, int& R, int& C) { const int st = b / 1024, sb = b % 1024, swz = sb ^ (((sb >> 9) & 1) << 5); R = (st >> 1) * 16 + swz / 64; C = (st & 1) * 32 + (swz % 64) / 2; }
struct Unit { int pm, pn, k0, nt, split; };
struct Gemm { const bf16_t* A; const bf16_t* Bt; int K; };
struct Sched {
    int nM, nN, nwg, G, c, ntF, nTail, tailPm0, tbase;
    __device__ __forceinline__ void init(int nM_, int nN_, int G_, int c_, int K, int tailRows  ) {
        nM = nM_; nN = nN_; nwg = nM * nN; G = G_; c = c_; ntF = K / BK; tbase = tailRows * nN; nTail = tbase * (K / 256); tailPm0 = nM_;
    }
    __device__ __forceinline__ bool next(int i, Unit& u) const {
        long L = (long)i * G + c;
        if (L < nwg) {
            int wgid = (int)L; { const int q = nwg / NXCD, r = nwg % NXCD, xcd = wgid % NXCD, off = wgid / NXCD; wgid = (xcd < r ? xcd * (q + 1) : r * (q + 1) + (xcd - r) * q) + off; }
            const int nig = WGM * nN, gid = wgid / nig, fm = gid * WGM, gsz = (nM - fm) < WGM ? (nM - fm) : WGM;
            u.pm = fm + ((wgid % nig) % gsz); u.pn = (wgid % nig) / gsz; u.k0 = 0; u.nt = ntF; u.split = 0; return true;
        }
        L -= nwg;
        if (L >= nTail) return false;
        const int ub = (int)L % tbase, s = (int)L / tbase;
        u.pm = tailPm0 + ub / nN; u.pn = ub % nN; u.k0 = s * 256; u.nt = 4; u.split = 1; return true;
    }
};

template <class Epi>
__device__ __forceinline__ void gemm_phase(LAS unsigned char* lds, const Gemm g, const Sched& S, const Epi& E) {
    const int tid = tidx(), wid = __builtin_amdgcn_readfirstlane(tid >> 6), lane = tid & 63, wr = wid >> 2, wc = wid & 3, fr = lane & 15, fq = lane >> 4;
    const int K = g.K;
    unsigned voffA[2];
#pragma unroll
    for (int i = 0; i < 2; ++i) { int R, C; stage_rc(tid * 16 + i * 8192, R, C); voffA[i] = (unsigned)(R * K + C) * 2u; }
    const size_t kstep = (size_t)(BK * 2);
    const size_t hstep = (size_t)HALF * K * 2;
    const size_t tstep = 2 * hstep;
    const unsigned ldsw = (unsigned)wid * 1024u;
    const int aoff = lds_byte(wr * 64 + fr, fq * 8), boff = lds_byte(wc * 32 + fr, fq * 8);
#define PG8_SA(b, h) (((b) * 2 + (h)) * HTB)
#define PG8_SB(b, h) ((4 + (b) * 2 + (h)) * HTB)
#define PG8_STAGE(bufoff, gbase, voff) do { _Pragma("unroll") for (int _i = 0; _i < 2; ++_i) \
        __builtin_amdgcn_global_load_lds((const unsigned*)((const char*)(gbase) + (voff)[_i]), (LAS unsigned*)(lds + (bufoff) + ldsw + _i * 8192), 16, 0, 0); } while (0)
#define PG8_LDA(dst, b, h) do { _Pragma("unroll") for (int m = 0; m < 4; ++m) _Pragma("unroll") for (int k = 0; k < 2; ++k) dst[m][k] = *(const LAS bf16x8*)(lds + PG8_SA(b, h) + aoff + m * 2048 + k * 1024); } while (0)
#define PG8_LDB(dst, b, h) do { _Pragma("unroll") for (int n = 0; n < 2; ++n) _Pragma("unroll") for (int k = 0; k < 2; ++k) dst[n][k] = *(const LAS bf16x8*)(lds + PG8_SB(b, h) + boff + n * 2048 + k * 1024); } while (0)
#define PG8_MMA(ai, bj, At, Bt) do { __builtin_amdgcn_s_setprio(1); _Pragma("unroll") for (int m = 0; m < 4; ++m) _Pragma("unroll") for (int n = 0; n < 2; ++n) _Pragma("unroll") for (int k = 0; k < 2; ++k) \
        acc[ai][bj][m][n] = __builtin_amdgcn_mfma_f32_16x16x32_bf16(Bt[n][k], At[m][k], acc[ai][bj][m][n], 0, 0, 0); __builtin_amdgcn_s_setprio(0); } while (0)
#define PG8_WAIT_V(n) asm volatile("s_waitcnt vmcnt(" #n ")" ::: "memory")
#define PG8_WAIT_L(n) asm volatile("s_waitcnt lgkmcnt(" #n ")" ::: "memory")
#define PG8_BAR __builtin_amdgcn_s_barrier()
#define PG8_SCHED __builtin_amdgcn_sched_barrier(0)
    Unit cur, nxt; int ui = 0;
    if (!S.next(0, cur)) return;
    f32x4 acc[2][2][4][2];
#pragma unroll
    for (int a = 0; a < 2; ++a)
#pragma unroll
        for (int b = 0; b < 2; ++b)
#pragma unroll
            for (int m = 0; m < 4; ++m)
#pragma unroll
                for (int n = 0; n < 2; ++n) acc[a][b][m][n] = (f32x4){0.f, 0.f, 0.f, 0.f};
    bf16x8 At[4][2], B0[2][2], B1[2][2];
    const char* cA = (const char*)g.A + (size_t)cur.pm * tstep + (size_t)cur.k0 * 2; const char* cB = (const char*)g.Bt + (size_t)cur.pn * tstep + (size_t)cur.k0 * 2;
    int nt = cur.nt;
    PG8_STAGE(PG8_SB(0, 0), cB, voffA); PG8_STAGE(PG8_SA(0, 0), cA, voffA); PG8_STAGE(PG8_SB(0, 1), cB + hstep, voffA); PG8_STAGE(PG8_SA(0, 1), cA + hstep, voffA);
    if (wr == 1) PG8_BAR;
    PG8_WAIT_V(4); PG8_BAR;
    PG8_STAGE(PG8_SB(1, 0), cB + kstep, voffA); PG8_STAGE(PG8_SA(1, 0), cA + kstep, voffA); PG8_STAGE(PG8_SB(1, 1), cB + hstep + kstep, voffA);
    PG8_WAIT_V(6); PG8_BAR;
    for (;;) {
        const bool has_next = S.next(ui + 1, nxt);
        const char* nA = has_next ? (const char*)g.A + (size_t)nxt.pm * tstep + (size_t)nxt.k0 * 2 : cA; const char* nB = has_next ? (const char*)g.Bt + (size_t)nxt.pn * tstep + (size_t)nxt.k0 * 2 : cB;
        for (int t = 0; t < nt; t += 2) {
            const bool last = (t == nt - 2);
            const char* a1 = cA + (size_t)(t + 1) * kstep;
            const char* a2 = last ? nA : cA + (size_t)(t + 2) * kstep; const char* b2 = last ? nB : cB + (size_t)(t + 2) * kstep;
            const char* a3 = a2 + kstep; const char* b3 = b2 + kstep;
            PG8_LDB(B0, 0, 0); PG8_SCHED; PG8_LDA(At, 0, 0); PG8_STAGE(PG8_SA(1, 1), a1 + hstep, voffA);
            PG8_WAIT_L(8); PG8_BAR; PG8_WAIT_L(0); PG8_MMA(0, 0, At, B0); PG8_BAR; PG8_SCHED;
            PG8_LDB(B1, 0, 1); PG8_STAGE(PG8_SB(0, 0), b2, voffA);
            PG8_BAR; PG8_WAIT_L(0); PG8_MMA(0, 1, At, B1); PG8_BAR;
            PG8_LDA(At, 0, 1); PG8_STAGE(PG8_SA(0, 0), a2, voffA);
            PG8_BAR; PG8_WAIT_L(0); PG8_MMA(1, 0, At, B0); PG8_BAR; PG8_SCHED;
            PG8_STAGE(PG8_SB(0, 1), b2 + hstep, voffA);
            PG8_WAIT_V(6); PG8_BAR; PG8_MMA(1, 1, At, B1); PG8_BAR;
            PG8_LDB(B0, 1, 0); PG8_SCHED; PG8_LDA(At, 1, 0); PG8_STAGE(PG8_SA(0, 1), a2 + hstep, voffA);
            PG8_WAIT_L(8); PG8_BAR; PG8_WAIT_L(0); PG8_MMA(0, 0, At, B0); PG8_BAR; PG8_SCHED;
            PG8_LDB(B1, 1, 1); PG8_STAGE(PG8_SB(1, 0), b3, voffA);
            PG8_BAR; PG8_WAIT_L(0); PG8_MMA(0, 1, At, B1); PG8_BAR;
            PG8_LDA(At, 1, 1); PG8_STAGE(PG8_SA(1, 0), a3, voffA);
            PG8_BAR; PG8_WAIT_L(0); PG8_MMA(1, 0, At, B0); PG8_BAR; PG8_SCHED;
            PG8_STAGE(PG8_SB(1, 1), b3 + hstep, voffA);
            PG8_WAIT_V(6); PG8_BAR; PG8_MMA(1, 1, At, B1); PG8_BAR;
        }
        E(acc, cur, wr, wc, fr, fq);
        if (!has_next) break;
#pragma unroll
        for (int a = 0; a < 2; ++a)
#pragma unroll
            for (int b = 0; b < 2; ++b)
#pragma unroll
                for (int m = 0; m < 4; ++m)
#pragma unroll
                    for (int n = 0; n < 2; ++n) acc[a][b][m][n] = (f32x4){0.f, 0.f, 0.f, 0.f};
        cur = nxt; cA = nA; cB = nB; nt = cur.nt; ++ui;
    }
    PG8_WAIT_V(0);
    if (wr == 0) PG8_BAR;
    PG8_BAR;
#undef PG8_SA
#undef PG8_SB
#undef PG8_STAGE
#undef PG8_LDA
#undef PG8_LDB
#undef PG8_MMA
#undef PG8_WAIT_V
#undef PG8_WAIT_L
#undef PG8_BAR
#undef PG8_SCHED
}
}

enum { EP_HG_IN = 0, EP_RW_IN, EP_RW_L2, EP_MB_IN, EP_RES, EP_FFN };
struct EpiArgs { void* p0; void* p1; void* p2; void* p3; const float* c0; const float* c1; int j; };
template <int MODE> struct Epi {
    EpiArgs a;
    __device__ __forceinline__ void st_bf4(bf16_t* p, f32x4 v) const { u32x2 w; w.x = cvt_pk_bf16(v[0], v[1]); w.y = cvt_pk_bf16(v[2], v[3]); *(u32x2*)p = w; }
    __device__ __forceinline__ void emit(int row, int col, f32x4 v, const pg8::Unit& u) const {
        if constexpr (MODE == EP_HG_IN) {
            const int seg = u.pn >> 2, cs = col & 1023;
            if (seg == 0) { f32x4 o; for (int i = 0; i < 4; ++i) o[i] = siluf_(v[i]); st_bf4((bf16_t*)a.p0 + (size_t)row * 1024 + cs, o); }
            else if (seg == 1) {
                f32x4 o;
                if (a.j) { const f32x4 l0 = ld4(a.c0 + cs), l1 = ld4(a.c0 + 1024 + cs);
                    for (int i = 0; i < 4; ++i) { const float lb = 1.0f / (1.0f + __expf(l0[i] - l1[i])); o[i] = lb + (1.0f - lb) * sigmoidf_(v[i]); } }
                else { for (int i = 0; i < 4; ++i) o[i] = sigmoidf_(v[i]); }
                *(f32x4*)((float*)a.p1 + (size_t)row * 1024 + cs) = o; }
            else if (seg == 2) { st_bf4((bf16_t*)a.p2 + (size_t)row * 1024 + cs, v); }
            else { f32x4 o; for (int i = 0; i < 4; ++i) o[i] = siluf_(v[i]); st_bf4((bf16_t*)a.p3 + (size_t)row * 1024 + cs, o); }
        } else if constexpr (MODE == EP_RW_IN) {
            if (u.pn < 12) st_bf4((bf16_t*)a.p0 + (size_t)row * 3072 + col, v);
            else { const int cs = col - 3072; f32x4 o;
                if (cs < 64) { for (int i = 0; i < 4; ++i) o[i] = tanhf(v[i]); } else if (cs < 128) o = v; else { for (int i = 0; i < 4; ++i) o[i] = sigmoidf_(v[i]); }
                st_bf4((bf16_t*)a.p1 + (size_t)row * 256 + cs, o); }
        } else if constexpr (MODE == EP_RW_L2) {
            const int seg = u.pn >> 2, cs = col & 1023;
            if (seg == 0) { const f32x4 w0 = ld4(a.c0 + cs); f32x4 o;
                for (int i = 0; i < 4; ++i) { const float wl = -softplusf_(-(w0[i] + v[i])) - 0.5f; o[i] = __expf(-__expf(wl)); }
                *(f32x4*)((float*)a.p0 + (size_t)row * 1024 + cs) = o; }
            else if (seg == 1) { const f32x4 a0 = ld4(a.c1 + cs); f32x4 o; for (int i = 0; i < 4; ++i) o[i] = sigmoidf_(a0[i] + v[i]); st_bf4((bf16_t*)a.p1 + (size_t)row * 1024 + cs, o); }
            else st_bf4((bf16_t*)a.p2 + (size_t)row * 1024 + cs, v);
        } else if constexpr (MODE == EP_MB_IN) {
            if (u.pn < 8) { f32x4 o; for (int i = 0; i < 4; ++i) o[i] = siluf_(v[i]); st_bf4((bf16_t*)a.p0 + (size_t)row * 2048 + col, o); }
            else if (u.pn < 20) st_bf4((bf16_t*)a.p1 + (size_t)row * 3072 + (col - 2048), v);
            else { const int cs = col - 5120; if (cs < 32) { const f32x4 b = ld4(a.c0 + cs); f32x4 o; for (int i = 0; i < 4; ++i) o[i] = softplusf_(v[i] + b[i]); *(f32x4*)((float*)a.p2 + (size_t)row * 32 + cs) = o; } }
        } else if constexpr (MODE == EP_RES) {
            float* x = (float*)a.p0 + (size_t)row * 1024 + col;
            if (u.split) { for (int i = 0; i < 4; ++i) unsafeAtomicAdd(x + i, v[i]); }
            else { f32x4 o = *(f32x4*)x; o += v; *(f32x4*)x = o; }
        }
    }
    __device__ __forceinline__ void operator()(const f32x4 (&acc)[2][2][4][2], const pg8::Unit& u, int wr, int wc, int fr, int fq) const {
        const int row0 = u.pm * 256 + wr * 64 + fr;
        if constexpr (MODE == EP_FFN) {
            bf16_t* act = (bf16_t*)a.p0;
#pragma unroll
            for (int ai = 0; ai < 2; ++ai)
#pragma unroll
                for (int m = 0; m < 4; ++m) { const int row = row0 + ai * 128 + m * 16;
#pragma unroll
                    for (int n = 0; n < 2; ++n) { const int j = u.pn * 128 + wc * 32 + n * 16 + 4 * fq; const f32x4 g = acc[ai][0][m][n], up = acc[ai][1][m][n]; f32x4 o;
                        for (int i = 0; i < 4; ++i) o[i] = siluf_(g[i]) * up[i];
                        st_bf4(act + (size_t)row * DFF + j, o); } }
        } else {
#pragma unroll
            for (int ai = 0; ai < 2; ++ai)
#pragma unroll
                for (int m = 0; m < 4; ++m) { const int row = row0 + ai * 128 + m * 16;
#pragma unroll
                    for (int bj = 0; bj < 2; ++bj)
#pragma unroll
                        for (int n = 0; n < 2; ++n) emit(row, u.pn * 256 + bj * 128 + wc * 32 + n * 16 + 4 * fq, acc[ai][bj][m][n], u); }
        }
    }
};

template <int MODE>
__device__ __forceinline__ void run_gemm(LAS unsigned char* lds, const bf16_t* A, const bf16_t* Bt, int K, int nN, bool resid, const EpiArgs& ea) {
    pg8::Gemm g{A, Bt, K}; pg8::Sched S;
    if (resid) S.init(64, nN, (int)gridDim.x, (int)blockIdx.x, K, 2); else { S.init(66, nN, (int)gridDim.x, (int)blockIdx.x, K, 0); }
    Epi<MODE> E{ea};
    pg8::gemm_phase<Epi<MODE>>(lds, g, S, E);
}

struct Job { const float* src; int Ks, Ns; bf16_t* dst; int ldd, coloff, rowmode, rowoff; const float* mu; int mumode; };
__device__ __forceinline__ void get_job(int j, const Params& p, bf16_t* WB, Job& J) {
    J.coloff = 0; J.rowmode = 0; J.rowoff = 0; J.mu = nullptr; J.mumode = 0;
    if (j < 12) { const int l = j / 3, t = j % 3;
        if (t == 0) { J.src = p.in[10] + (size_t)l * 1024 * 2816; J.Ks = 1024; J.Ns = 2816; J.dst = WB + W_GU + l * W_GU_SZ; J.ldd = 1024; J.rowmode = 1; }
        else if (t == 1) { J.src = p.in[11] + (size_t)l * 1024 * 2816; J.Ks = 1024; J.Ns = 2816; J.dst = WB + W_GU + l * W_GU_SZ; J.ldd = 1024; J.rowmode = 1; J.rowoff = 128; }
        else { J.src = p.in[12] + (size_t)l * 2816 * 1024; J.Ks = 2816; J.Ns = 1024; J.dst = WB + W_D + l * W_D_SZ; J.ldd = 2816; }
    } else if (j < 16) { const int q = j - 12, jj = q >> 1;
        if ((q & 1) == 0) { J.src = p.in[13] + (size_t)jj * 1024 * 4096; J.Ks = 1024; J.Ns = 4096; J.dst = WB + W_HGIN + jj * W_HGIN_SZ; J.ldd = 1024; }
        else { J.src = p.in[16] + (size_t)jj * 1024 * 1024; J.Ks = 1024; J.Ns = 1024; J.dst = WB + W_HGOUT + jj * W_HGOUT_SZ; J.ldd = 1024; }
    } else if (j < 28) { const int q = j - 16, s = q >> 1, half = q & 1;
        J.Ks = 1024; J.ldd = 2048; J.dst = WB + W_RWIN; J.coloff = half * 1024; J.mu = p.in[17] + s * 1024; J.mumode = 1 + half;
        if (s < 3) { J.src = p.in[18] + (size_t)s * 1024 * 1024; J.Ns = 1024; J.rowoff = 1024 * s; }
        else if (s == 3) { J.src = p.in[20]; J.Ns = 64; J.rowoff = 3072; }
        else if (s == 4) { J.src = p.in[23]; J.Ns = 64; J.rowoff = 3136; }
        else { J.src = p.in[25]; J.Ns = 128; J.rowoff = 3200; }
    } else if (j == 28) { J.src = p.in[32]; J.Ks = 1024; J.Ns = 1024; J.dst = WB + W_RWOUT; J.ldd = 1024; }
    else if (j == 29) { J.src = p.in[33]; J.Ks = 1024; J.Ns = 5152; J.dst = WB + W_MBIN; J.ldd = 1024; }
    else { J.src = p.in[40]; J.Ks = 2048; J.Ns = 1024; J.dst = WB + W_MBOUT; J.ldd = 2048; }
}
__device__ __forceinline__ void convert_weights(const Params& p, LAS float* tl  ) {
    bf16_t* WB = (bf16_t*)(p.ws + WS_WB);
    const int tid = tidx(), G = gridDim.x;
    int base = 0;
    for (int j = 0; j < 31; ++j) {
        Job J; get_job(j, p, WB, J);
        const int tk = J.Ks / 64, tn = (J.Ns + 63) / 64, ntile = tk * tn;
        int first = ((int)blockIdx.x - base % G + G) % G;
        for (int t = first; t < ntile; t += G) {
            const int k0 = (t / tn) * 64, n0 = (t % tn) * 64;
            __syncthreads();
#pragma unroll
            for (int r = 0; r < 2; ++r) { const int kk = (tid >> 4) + 32 * r, n4 = (tid & 15) * 4;
                f32x4 v = (f32x4){0.f, 0.f, 0.f, 0.f};
                if (n0 + n4 < J.Ns) v = ld4(J.src + (size_t)(k0 + kk) * J.Ns + n0 + n4);
                if (J.mumode) { const float m = J.mu[k0 + kk]; const float s = (J.mumode == 1) ? (1.0f - m) : m; v *= s; }
                tl[kk * 65 + n4] = v[0]; tl[kk * 65 + n4 + 1] = v[1]; tl[kk * 65 + n4 + 2] = v[2]; tl[kk * 65 + n4 + 3] = v[3]; }
            __syncthreads();
            const int n = tid >> 3, k8 = (tid & 7) * 8;
            if (n0 + n < J.Ns) {
                float f[8];
#pragma unroll
                for (int i = 0; i < 8; ++i) f[i] = tl[(k8 + i) * 65 + n];
                u32x4 w; w.x = cvt_pk_bf16(f[0], f[1]); w.y = cvt_pk_bf16(f[2], f[3]); w.z = cvt_pk_bf16(f[4], f[5]); w.w = cvt_pk_bf16(f[6], f[7]);
                const int ns = n0 + n; const int drow = (J.rowmode ? ((ns >> 7) * 256 + (ns & 127)) : ns) + J.rowoff;
                *(u32x4*)(J.dst + (size_t)drow * J.ldd + J.coloff + k0 + k8) = w;
            }
        }
        base += ntile;
    }
    const size_t gt = (size_t)blockIdx.x * 512 + tid, gs = (size_t)G * 512;
    bf16_t* L2 = WB + W_RWL2;
    for (size_t i = gt; i < (size_t)3072 * 256; i += gs) { const int n = (int)(i % 3072), c = (int)(i / 3072), s = n >> 10, d = n & 1023; float v = 0.f;
        if (s == 0 && c < 64) v = p.in[21][(size_t)c * 1024 + d]; else if (s == 1 && c >= 64 && c < 128) v = p.in[24][(size_t)(c - 64) * 1024 + d]; else if (s == 2 && c >= 128) v = p.in[26][(size_t)(c - 128) * 1024 + d];
        L2[(size_t)n * 256 + c] = (bf16_t)(cvt_pk_bf16(v, 0.f) & 0xffffu); }
    unsigned* zp = (unsigned*)(WB + W_MBIN + (size_t)5152 * 1024);
    for (size_t i = gt; i < (size_t)224 * 1024 / 2; i += gs) zp[i] = 0u;
}

__device__ __forceinline__ void norm_phase(const Params& p, int mode, const float* gvec, bool from_input) {
    const int tid_ = tidx(), lane = tid_ & 63, gw = blockIdx.x * 8 + (tid_ >> 6), nw = gridDim.x * 8;
    float* X = p.out; bf16_t* A1 = (bf16_t*)(p.ws + WS_B0);
    f32x4 g[4];
#pragma unroll
    for (int i = 0; i < 4; ++i) g[i] = ld4(gvec + 4 * (lane + 64 * i));
    for (int m = gw; m < NT; m += nw) {
        const float* src = from_input ? (m < NP ? p.in[0] + (size_t)m * D : p.in[1] + (size_t)(m - NP) * D) : X + (size_t)m * D;
        f32x4 v[4]; float ss = 0.f;
#pragma unroll
        for (int i = 0; i < 4; ++i) { v[i] = ld4(src + 4 * (lane + 64 * i)); ss += v[i][0] * v[i][0] + v[i][1] * v[i][1] + v[i][2] * v[i][2] + v[i][3] * v[i][3]; }
        ss = red64(ss);
        const float rstd = rsqrtf(ss * (1.0f / 1024.0f) + NORM_EPS);
        if (from_input) {
#pragma unroll
            for (int i = 0; i < 4; ++i) *(f32x4*)(X + (size_t)m * D + 4 * (lane + 64 * i)) = v[i]; }
#pragma unroll
        for (int i = 0; i < 4; ++i) v[i] = v[i] * rstd * g[i];
        if (mode == 2) {
#pragma unroll
            for (int i = 0; i < 4; ++i) *(f32x4*)(X + (size_t)m * D + 4 * (lane + 64 * i)) = v[i];
        } else if (mode == 0) {
#pragma unroll
            for (int i = 0; i < 4; ++i) { u32x2 w; w.x = cvt_pk_bf16(v[i][0], v[i][1]); w.y = cvt_pk_bf16(v[i][2], v[i][3]); *(u32x2*)(A1 + (size_t)m * 1024 + 4 * (lane + 64 * i)) = w; }
        } else {
            const bool pr = m < NP; const int t = pr ? (m & 2047) : ((m - NP) & 3); const int T = pr ? 2048 : 4; const int b = pr ? (m >> 11) : ((m - NP) >> 2);
            const bool last = (t == T - 1), first = (t == 0);
#pragma unroll
            for (int i = 0; i < 4; ++i) { const int c = 4 * (lane + 64 * i); u32x2 w; w.x = cvt_pk_bf16(v[i][0], v[i][1]); w.y = cvt_pk_bf16(v[i][2], v[i][3]);
                *(u32x2*)(A1 + (size_t)m * 2048 + c) = w;
                if (!last) *(u32x2*)(A1 + (size_t)(m + 1) * 2048 + 1024 + c) = w;
                else *(f32x4*)(p.out + (pr ? O_SHP : O_SHS) + (size_t)b * 1024 + c) = v[i];
                if (first) { u32x2 z; z.x = 0u; z.y = 0u; if (!pr) { const f32x4 s = ld4(p.in[4] + (size_t)b * 1024 + c); z.x = cvt_pk_bf16(s[0], s[1]); z.y = cvt_pk_bf16(s[2], s[3]); }
                    *(u32x2*)(A1 + (size_t)m * 2048 + 1024 + c) = z; } }
        }
    }
}

__device__ __forceinline__ void hgrn_scan(const Params& p, int j, LAS unsigned char* lds) {
    const bf16_t* Q = (const bf16_t*)(p.ws + WS_B1); const bf16_t* V = Q + (size_t)NT * 1024; const float* F = (const float*)(p.ws + WS_B2); float* O = (float*)(p.ws + WS_B3);
    LAS float* f_s = (LAS float*)lds; LAS float* q_s = f_s + 32 * 128; LAS float* v_s = q_s + 32 * 128; LAS float* op_s = v_s + 32 * 32;
    const int tid = tidx(), w = tid >> 6, l = tid & 63, vloc = l & 31, kg = w * 2 + (l >> 5);
    for (int task = blockIdx.x; task < 256 + 4096; task += gridDim.x) {
        int b, h, qv, T, row0; const float* S0; float* So;
        if (task < 256) { b = task >> 5; h = (task >> 2) & 7; qv = task & 3; T = 2048; row0 = b * 2048; S0 = nullptr; So = p.out + O_HGP + ((size_t)(j * 8 + b) * 8 + h) * 16384; }
        else { const int u = task - 256; b = u >> 5; h = (u >> 2) & 7; qv = u & 3; T = 4; row0 = NP + b * 4; S0 = p.in[2] + ((size_t)(j * 128 + b) * 8 + h) * 16384; So = p.out + O_HGS + ((size_t)(j * 128 + b) * 8 + h) * 16384; }
        const int col0 = h * 128, vc = qv * 32 + vloc;
        float S[8];
#pragma unroll
        for (int i = 0; i < 8; ++i) S[i] = S0 ? S0[(size_t)(kg * 8 + i) * 128 + vc] : 0.f;
        const int nb = (T + 31) >> 5;
        f32x4 pf[2]; u32x4 pq, pv;
        auto loadb = [&](int bt) {
            const int t0 = bt * 32, ntok = min(32, T - t0);
#pragma unroll
            for (int r = 0; r < 2; ++r) { const int idx = tid + 512 * r, tok = idx >> 5, c4 = idx & 31; if (tok < ntok) pf[r] = ld4(F + (size_t)(row0 + t0 + tok) * 1024 + col0 + c4 * 4); }
            { const int tok = tid >> 4, c8 = tid & 15; if (tok < ntok) pq = *(const u32x4*)(Q + (size_t)(row0 + t0 + tok) * 1024 + col0 + c8 * 8); }
            if (tid < 128) { const int tok = tid >> 2, c8 = tid & 3; if (tok < ntok) pv = *(const u32x4*)(V + (size_t)(row0 + t0 + tok) * 1024 + col0 + qv * 32 + c8 * 8); }
        };
        loadb(0);
        for (int bt = 0; bt < nb; ++bt) {
            const int t0 = bt * 32, ntok = min(32, T - t0);
            __syncthreads();
#pragma unroll
            for (int r = 0; r < 2; ++r) { const int idx = tid + 512 * r, tok = idx >> 5, c4 = idx & 31; if (tok < ntok) *(LAS f32x4*)(f_s + tok * 128 + c4 * 4) = pf[r]; }
            { const int tok = tid >> 4, c8 = tid & 15; if (tok < ntok) {
                *(LAS f32x4*)(q_s + tok * 128 + c8 * 8) = (f32x4){bflo(pq.x), bfhi(pq.x), bflo(pq.y), bfhi(pq.y)};
                *(LAS f32x4*)(q_s + tok * 128 + c8 * 8 + 4) = (f32x4){bflo(pq.z), bfhi(pq.z), bflo(pq.w), bfhi(pq.w)}; } }
            if (tid < 128) { const int tok = tid >> 2, c8 = tid & 3; if (tok < ntok) {
                *(LAS f32x4*)(v_s + tok * 32 + c8 * 8) = (f32x4){bflo(pv.x), bfhi(pv.x), bflo(pv.y), bfhi(pv.y)};
                *(LAS f32x4*)(v_s + tok * 32 + c8 * 8 + 4) = (f32x4){bflo(pv.z), bfhi(pv.z), bflo(pv.w), bfhi(pv.w)}; } }
            __syncthreads();
            if (bt + 1 < nb) loadb(bt + 1);
            for (int t = 0; t < ntok; ++t) {
                const f32x4 fa = *(const LAS f32x4*)(f_s + t * 128 + kg * 8), fb = *(const LAS f32x4*)(f_s + t * 128 + kg * 8 + 4);
                const f32x4 qa = *(const LAS f32x4*)(q_s + t * 128 + kg * 8), qb = *(const LAS f32x4*)(q_s + t * 128 + kg * 8 + 4);
                const float vv = v_s[t * 32 + vloc];
                float pa = 0.f, pb = 0.f;
#pragma unroll
                for (int i = 0; i < 4; ++i) { S[i] = vv + fa[i] * (S[i] - vv); pa += S[i] * qa[i]; S[4 + i] = vv + fb[i] * (S[4 + i] - vv); pb += S[4 + i] * qb[i]; }
                op_s[(t * 16 + kg) * 32 + vloc] = pa + pb;
            }
            __syncthreads();
#pragma unroll
            for (int r = 0; r < 2; ++r) { const int idx = tid + 512 * r, tok = idx >> 5, vl = idx & 31;
                if (tok < ntok) { float s = 0.f;
#pragma unroll
                    for (int gq = 0; gq < 16; ++gq) s += op_s[(tok * 16 + gq) * 32 + vl];
                    O[(size_t)(row0 + t0 + tok) * 1024 + col0 + qv * 32 + vl] = s; } }
        }
#pragma unroll
        for (int i = 0; i < 8; ++i) So[(size_t)(kg * 8 + i) * 128 + vc] = S[i];
    }
}
__device__ __forceinline__ void hgrn_post(const Params& p, int j) {
    const float* O = (const float*)(p.ws + WS_B3); const bf16_t* Gt = (const bf16_t*)(p.ws + WS_B1) + (size_t)2 * NT * 1024; bf16_t* A2 = (bf16_t*)(p.ws + WS_B3 + 66 * MiB);
    const int tid_ = tidx(), lane = tid_ & 63, gw = blockIdx.x * 8 + (tid_ >> 6), nw = gridDim.x * 8;
    const float* ng = p.in[15] + j * 128 + (lane & 7) * 16;
    for (int m = gw; m < NT; m += nw) {
        const size_t off = (size_t)m * 1024 + lane * 16;
        f32x4 o[4]; float ss = 0.f;
#pragma unroll
        for (int i = 0; i < 4; ++i) { o[i] = ld4(O + off + 4 * i); ss += o[i][0] * o[i][0] + o[i][1] * o[i][1] + o[i][2] * o[i][2] + o[i][3] * o[i][3]; }
        ss = red8(ss);
        const float rstd = rsqrtf(ss * (1.0f / 128.0f) + NORM_EPS);
        const u32x4 g0 = *(const u32x4*)(Gt + off), g1 = *(const u32x4*)(Gt + off + 8);
        const float gf[16] = {bflo(g0.x), bfhi(g0.x), bflo(g0.y), bfhi(g0.y), bflo(g0.z), bfhi(g0.z), bflo(g0.w), bfhi(g0.w), bflo(g1.x), bfhi(g1.x), bflo(g1.y), bfhi(g1.y), bflo(g1.z), bfhi(g1.z), bflo(g1.w), bfhi(g1.w)};
        float r[16];
#pragma unroll
        for (int i = 0; i < 4; ++i) { const f32x4 n4 = ld4(ng + 4 * i);
#pragma unroll
            for (int q = 0; q < 4; ++q) r[4 * i + q] = o[i][q] * rstd * n4[q] * gf[4 * i + q]; }
        u32x4 w0, w1; w0.x = cvt_pk_bf16(r[0], r[1]); w0.y = cvt_pk_bf16(r[2], r[3]); w0.z = cvt_pk_bf16(r[4], r[5]); w0.w = cvt_pk_bf16(r[6], r[7]);
        w1.x = cvt_pk_bf16(r[8], r[9]); w1.y = cvt_pk_bf16(r[10], r[11]); w1.z = cvt_pk_bf16(r[12], r[13]); w1.w = cvt_pk_bf16(r[14], r[15]);
        *(u32x4*)(A2 + off) = w0; *(u32x4*)(A2 + off + 8) = w1;
    }
}

__device__ __forceinline__ void rwkv_scan(const Params& p, LAS unsigned char* lds) {
    const bf16_t* RKV = (const bf16_t*)(p.ws + WS_B1); const float* DEC = (const float*)(p.ws + WS_B2); const bf16_t* AA = (const bf16_t*)(p.ws + WS_B3);
    float* O = (float*)(p.ws + WS_B0); float* RHO = (float*)(p.ws + WS_B4);
    LAS float* w_s = (LAS float*)lds; LAS float* n_s = w_s + 2048; LAS float* ka_s = n_s + 2048; LAS float* kp_s = ka_s + 2048; LAS float* r_s = kp_s + 2048; LAS float* v_s = r_s + 2048; LAS float* o_s = v_s + 1024;
    const int tid = tidx(), w = tid >> 6, l = tid & 63;
    const int stok = tid >> 4, sc = tid & 15;
    const int g = l >> 4, c = l & 15, vr0 = 8 * w + 2 * g;
    for (int task = blockIdx.x; task < 256 + 4096; task += gridDim.x) {
        int b, h, half, T, row0; const float* S0; float* So;
        if (task < 256) { b = task >> 5; h = (task >> 1) & 15; half = task & 1; T = 2048; row0 = b * 2048; S0 = nullptr; So = p.out + O_WKVP + ((size_t)b * 16 + h) * 4096; }
        else { const int u = task - 256; b = u >> 5; h = (u >> 1) & 15; half = u & 1; T = 4; row0 = NP + b * 4; S0 = p.in[3] + ((size_t)b * 16 + h) * 4096; So = p.out + O_WKVS + ((size_t)b * 16 + h) * 4096; }
        const int ch = h * 64 + 4 * sc;
        const f32x4 kk4 = ld4(p.in[27] + ch), ka4 = ld4(p.in[28] + ch), rk4 = ld4(p.in[29] + ch);
        f32x4 S0r = (f32x4){0.f, 0.f, 0.f, 0.f}, S1r = S0r;
        if (w < 4 && S0) { S0r = ld4(S0 + (size_t)(half * 32 + vr0) * 64 + 4 * c); S1r = ld4(S0 + (size_t)(half * 32 + vr0 + 1) * 64 + 4 * c); }
        const int nb = (T + 31) >> 5;
        u32x2 pr, pk, pv, pa; f32x4 pd;
        auto loadb = [&](int bt) {
            const int t0 = bt * 32, ntok = min(32, T - t0);
            if (stok < ntok) { const size_t m = (size_t)(row0 + t0 + stok);
                pr = *(const u32x2*)(RKV + m * 3072 + ch); pk = *(const u32x2*)(RKV + m * 3072 + 1024 + ch); pv = *(const u32x2*)(RKV + m * 3072 + 2048 + ch);
                pd = ld4(DEC + m * 1024 + ch); pa = *(const u32x2*)(AA + m * 1024 + ch); }
        };
        loadb(0);
        for (int bt = 0; bt < nb; ++bt) {
            const int t0 = bt * 32, ntok = min(32, T - t0);
            __syncthreads();
            if (stok < ntok) {
                const f32x4 kf = (f32x4){bflo(pk.x), bfhi(pk.x), bflo(pk.y), bfhi(pk.y)}, rf = (f32x4){bflo(pr.x), bfhi(pr.x), bflo(pr.y), bfhi(pr.y)};
                const f32x4 vf = (f32x4){bflo(pv.x), bfhi(pv.x), bflo(pv.y), bfhi(pv.y)}, af = (f32x4){bflo(pa.x), bfhi(pa.x), bflo(pa.y), bfhi(pa.y)};
                f32x4 kr = kf * kk4; float ss = kr[0] * kr[0] + kr[1] * kr[1] + kr[2] * kr[2] + kr[3] * kr[3];
                ss = red16(ss);
                const float inv = rsqrtf(fmaxf(ss, 1e-24f));
                const f32x4 kn = kr * inv;
                const f32x4 kp = kf * (1.0f + (af - 1.0f) * ka4);
                float rho = rf[0] * kp[0] * rk4[0] + rf[1] * kp[1] * rk4[1] + rf[2] * kp[2] * rk4[2] + rf[3] * kp[3] * rk4[3];
                rho = red16(rho);
                if (half == 0 && sc == 0) RHO[(size_t)(row0 + t0 + stok) * 16 + h] = rho;
                *(LAS f32x4*)(w_s + stok * 64 + 4 * sc) = pd; *(LAS f32x4*)(n_s + stok * 64 + 4 * sc) = -kn; *(LAS f32x4*)(ka_s + stok * 64 + 4 * sc) = kn * af;
                *(LAS f32x4*)(kp_s + stok * 64 + 4 * sc) = kp; *(LAS f32x4*)(r_s + stok * 64 + 4 * sc) = rf;
                if ((sc >> 3) == half) *(LAS f32x4*)(v_s + stok * 32 + (sc & 7) * 4) = vf;
            }
            __syncthreads();
            if (bt + 1 < nb) loadb(bt + 1);
            if (w < 4) {
                for (int t = 0; t < ntok; ++t) {
                    const f32x4 w4 = *(const LAS f32x4*)(w_s + t * 64 + 4 * c), n4 = *(const LAS f32x4*)(n_s + t * 64 + 4 * c), k4 = *(const LAS f32x4*)(ka_s + t * 64 + 4 * c);
                    const f32x4 p4 = *(const LAS f32x4*)(kp_s + t * 64 + 4 * c), r4 = *(const LAS f32x4*)(r_s + t * 64 + 4 * c);
                    const f32x2 vv = *(const LAS f32x2*)(v_s + t * 32 + vr0);
                    float sa0 = S0r[0] * n4[0] + S0r[1] * n4[1] + S0r[2] * n4[2] + S0r[3] * n4[3];
                    float sa1 = S1r[0] * n4[0] + S1r[1] * n4[1] + S1r[2] * n4[2] + S1r[3] * n4[3];
                    sa0 = red16(sa0); sa1 = red16(sa1);
                    S0r = S0r * w4 + sa0 * k4 + vv.x * p4;
                    S1r = S1r * w4 + sa1 * k4 + vv.y * p4;
                    float o0 = S0r[0] * r4[0] + S0r[1] * r4[1] + S0r[2] * r4[2] + S0r[3] * r4[3];
                    float o1 = S1r[0] * r4[0] + S1r[1] * r4[1] + S1r[2] * r4[2] + S1r[3] * r4[3];
                    o0 = red16(o0); o1 = red16(o1);
                    if (c == 0) *(LAS f32x2*)(o_s + t * 32 + vr0) = (f32x2){o0, o1};
                }
            }
            __syncthreads();
#pragma unroll
            for (int r = 0; r < 2; ++r) { const int idx = tid + 512 * r, tok = idx >> 5, vl = idx & 31;
                if (tok < ntok) O[(size_t)(row0 + t0 + tok) * 1024 + h * 64 + half * 32 + vl] = o_s[tok * 32 + vl]; }
        }
        if (w < 4) { *(f32x4*)(So + (size_t)(half * 32 + vr0) * 64 + 4 * c) = S0r; *(f32x4*)(So + (size_t)(half * 32 + vr0 + 1) * 64 + 4 * c) = S1r; }
    }
}
__device__ __forceinline__ void rwkv_post(const Params& p) {
    const float* O = (const float*)(p.ws + WS_B0); const bf16_t* RKV = (const bf16_t*)(p.ws + WS_B1); const bf16_t* GATE = (const bf16_t*)(p.ws + WS_B3) + (size_t)NT * 1024;
    const float* RHO = (const float*)(p.ws + WS_B4); bf16_t* A2 = (bf16_t*)(p.ws + WS_B2);
    const int tid_ = tidx(), lane = tid_ & 63, gw = blockIdx.x * 8 + (tid_ >> 6), nw = gridDim.x * 8;
    for (int m = gw; m < NT; m += nw) {
        const size_t off = (size_t)m * 1024 + lane * 16;
        f32x4 o[4]; float s = 0.f;
#pragma unroll
        for (int i = 0; i < 4; ++i) { o[i] = ld4(O + off + 4 * i); s += o[i][0] + o[i][1] + o[i][2] + o[i][3]; }
        s = red4(s); const float mean = s * (1.0f / 64.0f); float q = 0.f;
#pragma unroll
        for (int i = 0; i < 4; ++i) { o[i] = o[i] - mean; q += o[i][0] * o[i][0] + o[i][1] * o[i][1] + o[i][2] * o[i][2] + o[i][3] * o[i][3]; }
        q = red4(q); const float rstd = rsqrtf(q * (1.0f / 64.0f) + 64e-5f);
        const float rho = RHO[(size_t)m * 16 + (lane >> 2)];
        const u32x4 v0 = *(const u32x4*)(RKV + (size_t)m * 3072 + 2048 + lane * 16), v1 = *(const u32x4*)(RKV + (size_t)m * 3072 + 2048 + lane * 16 + 8);
        const u32x4 g0 = *(const u32x4*)(GATE + off), g1 = *(const u32x4*)(GATE + off + 8);
        const float vf[16] = {bflo(v0.x), bfhi(v0.x), bflo(v0.y), bfhi(v0.y), bflo(v0.z), bfhi(v0.z), bflo(v0.w), bfhi(v0.w), bflo(v1.x), bfhi(v1.x), bflo(v1.y), bfhi(v1.y), bflo(v1.z), bfhi(v1.z), bflo(v1.w), bfhi(v1.w)};
        const float gf[16] = {bflo(g0.x), bfhi(g0.x), bflo(g0.y), bfhi(g0.y), bflo(g0.z), bfhi(g0.z), bflo(g0.w), bfhi(g0.w), bflo(g1.x), bfhi(g1.x), bflo(g1.y), bfhi(g1.y), bflo(g1.z), bfhi(g1.z), bflo(g1.w), bfhi(g1.w)};
        float r[16];
#pragma unroll
        for (int i = 0; i < 4; ++i) { const f32x4 lw = ld4(p.in[30] + lane * 16 + 4 * i), lb = ld4(p.in[31] + lane * 16 + 4 * i);
#pragma unroll
            for (int qq = 0; qq < 4; ++qq) r[4 * i + qq] = (o[i][qq] * rstd * lw[qq] + lb[qq] + rho * vf[4 * i + qq]) * gf[4 * i + qq]; }
        u32x4 w0, w1; w0.x = cvt_pk_bf16(r[0], r[1]); w0.y = cvt_pk_bf16(r[2], r[3]); w0.z = cvt_pk_bf16(r[4], r[5]); w0.w = cvt_pk_bf16(r[6], r[7]);
        w1.x = cvt_pk_bf16(r[8], r[9]); w1.y = cvt_pk_bf16(r[10], r[11]); w1.z = cvt_pk_bf16(r[12], r[13]); w1.w = cvt_pk_bf16(r[14], r[15]);
        *(u32x4*)(A2 + off) = w0; *(u32x4*)(A2 + off + 8) = w1;
    }
}

__device__ __forceinline__ void mamba_scan(const Params& p, LAS unsigned char* lds) {
    const bf16_t* XBC = (const bf16_t*)(p.ws + WS_B1); const float* DT = (const float*)(p.ws + WS_B4); bf16_t* Y = (bf16_t*)(p.ws + WS_B3);
    const int tid = tidx(), w = tid >> 6, l = tid & 63, G = gridDim.x;
    for (size_t i = (size_t)blockIdx.x * 512 + tid; i < (size_t)136 * 3 * 384; i += (size_t)G * 512) {
        const int c8 = (int)(i % 384), rr = (int)((i / 384) % 3), sq = (int)(i / (384 * 3));
        const size_t m = sq < 8 ? (size_t)sq * 2048 + 2045 + rr : (size_t)NP + (size_t)(sq - 8) * 4 + 1 + rr;
        float* dst = sq < 8 ? p.out + O_CVP + ((size_t)sq * 3 + rr) * 3072 + c8 * 8 : p.out + O_CVS + ((size_t)(sq - 8) * 3 + rr) * 3072 + c8 * 8;
        const u32x4 x = *(const u32x4*)(XBC + m * 3072 + c8 * 8);
        *(f32x4*)dst = (f32x4){bflo(x.x), bfhi(x.x), bflo(x.y), bfhi(x.y)}; *(f32x4*)(dst + 4) = (f32x4){bflo(x.z), bfhi(x.z), bflo(x.w), bfhi(x.w)};
    }
    LAS float* raw_s = (LAS float*)lds;
    LAS float* xd_s = raw_s + 19 * 320;
    LAS float* x_s = xd_s + 16 * 64;
    LAS float* B_s = x_s + 16 * 64;
    LAS float* C_s = B_s + 16 * 128;
    LAS float* dt_s = C_s + 16 * 128;
    LAS float* yp_s = dt_s + 32;
    const int pl = l >> 2, nlo = l & 3, p0 = 4 * pl, n0 = 16 * w + 4 * nlo;
    for (int task = blockIdx.x; task < 256 + 4096; task += G) {
        int b, hd, T, row0; const float* S0; float* So; const float* cv0;
        if (task < 256) { b = task >> 5; hd = task & 31; T = 2048; row0 = b * 2048; S0 = nullptr; cv0 = nullptr; So = p.out + O_SSMP + ((size_t)b * 32 + hd) * 8192; }
        else { const int u = task - 256; b = u >> 5; hd = u & 31; T = 4; row0 = NP + b * 4; S0 = p.in[5] + ((size_t)b * 32 + hd) * 8192; cv0 = p.in[6] + (size_t)b * 3 * 3072; So = p.out + O_SSMS + ((size_t)b * 32 + hd) * 8192; }
        const int grp = hd >> 3;
        const float Aneg = -__expf(p.in[37][hd]), Dsk = p.in[38][hd];
        int gch = 0; float cw0 = 0.f, cw1 = 0.f, cw2 = 0.f, cw3 = 0.f, cbias = 0.f;
        if (tid < 320) { gch = tid < 64 ? hd * 64 + tid : (tid < 192 ? 2048 + grp * 128 + (tid - 64) : 2560 + grp * 128 + (tid - 192));
            cw0 = p.in[34][gch]; cw1 = p.in[34][3072 + gch]; cw2 = p.in[34][2 * 3072 + gch]; cw3 = p.in[34][3 * 3072 + gch]; cbias = p.in[35][gch]; }
        f32x4 hs[4];
#pragma unroll
        for (int jj = 0; jj < 4; ++jj) hs[jj] = S0 ? ld4(S0 + (size_t)(p0 + jj) * 128 + n0) : (f32x4){0.f, 0.f, 0.f, 0.f};
        const int nb = (T + 15) >> 4;
        u32x4 pre[2]; float pdt = 0.f;
        auto loadb = [&](int bt) {
            const int t0 = bt * 16, ntok = min(16, T - t0);
#pragma unroll
            for (int r = 0; r < 2; ++r) { const int gi = tid + 512 * r; if (gi < 760) { const int rr = gi / 40, c8 = gi % 40, tt = t0 - 3 + rr, lc = c8 * 8;
                    const int gc = lc < 64 ? hd * 64 + lc : (lc < 192 ? 2048 + grp * 128 + (lc - 64) : 2560 + grp * 128 + (lc - 192));
                    if (tt >= 0 && tt < t0 + ntok) pre[r] = *(const u32x4*)(XBC + (size_t)(row0 + tt) * 3072 + gc); } }
            if (tid < ntok) pdt = DT[(size_t)(row0 + t0 + tid) * 32 + hd];
        };
        loadb(0);
        for (int bt = 0; bt < nb; ++bt) {
            const int t0 = bt * 16, ntok = min(16, T - t0);
            __syncthreads();
#pragma unroll
            for (int r = 0; r < 2; ++r) { const int gi = tid + 512 * r; if (gi < 760) { const int rr = gi / 40, c8 = gi % 40, tt = t0 - 3 + rr, lc = c8 * 8;
                    f32x4 a = (f32x4){0.f, 0.f, 0.f, 0.f}, c = a;
                    if (tt >= 0) { if (tt < t0 + ntok) { const u32x4 x = pre[r]; a = (f32x4){bflo(x.x), bfhi(x.x), bflo(x.y), bfhi(x.y)}; c = (f32x4){bflo(x.z), bfhi(x.z), bflo(x.w), bfhi(x.w)}; } }
                    else if (cv0) { const int gc = lc < 64 ? hd * 64 + lc : (lc < 192 ? 2048 + grp * 128 + (lc - 64) : 2560 + grp * 128 + (lc - 192));
                        a = ld4(cv0 + (size_t)(3 + tt) * 3072 + gc); c = ld4(cv0 + (size_t)(3 + tt) * 3072 + gc + 4); }
                    *(LAS f32x4*)(raw_s + rr * 320 + lc) = a; *(LAS f32x4*)(raw_s + rr * 320 + lc + 4) = c; } }
            if (tid < ntok) { dt_s[tid] = pdt; dt_s[16 + tid] = __expf(pdt * Aneg); }
            __syncthreads();
            if (bt + 1 < nb) loadb(bt + 1);
            if (tid < 320) {
                float r0 = raw_s[0 * 320 + tid], r1 = raw_s[1 * 320 + tid], r2 = raw_s[2 * 320 + tid];
                for (int t = 0; t < ntok; ++t) {
                    const float r3 = raw_s[(t + 3) * 320 + tid];
                    const float cv = cbias + r0 * cw0 + r1 * cw1 + r2 * cw2 + r3 * cw3;
                    const float val = siluf_(cv);
                    if (tid < 64) { x_s[t * 64 + tid] = val; xd_s[t * 64 + tid] = val * dt_s[t]; }
                    else if (tid < 192) B_s[t * 128 + tid - 64] = val; else C_s[t * 128 + tid - 192] = val;
                    r0 = r1; r1 = r2; r2 = r3;
                }
            }
            __syncthreads();
            for (int t = 0; t < ntok; ++t) {
                const f32x4 B4 = *(const LAS f32x4*)(B_s + t * 128 + n0), C4 = *(const LAS f32x4*)(C_s + t * 128 + n0), xd = *(const LAS f32x4*)(xd_s + t * 64 + p0);
                const float dA = dt_s[16 + t];
                f32x4 y;
#pragma unroll
                for (int jj = 0; jj < 4; ++jj) { hs[jj] = hs[jj] * dA + xd[jj] * B4; const f32x4 pr = hs[jj] * C4; y[jj] = red4((pr[0] + pr[1]) + (pr[2] + pr[3])); }
                if (nlo == 0) *(LAS f32x4*)(yp_s + (t * 8 + w) * 64 + p0) = y;
            }
            __syncthreads();
#pragma unroll
            for (int r = 0; r < 2; ++r) { const int idx = tid + 512 * r, tok = idx >> 6, pp = idx & 63;
                if (tok < ntok) { float s = Dsk * x_s[tok * 64 + pp];
#pragma unroll
                    for (int ww = 0; ww < 8; ++ww) s += yp_s[(tok * 8 + ww) * 64 + pp];
                    Y[(size_t)(row0 + t0 + tok) * 2048 + hd * 64 + pp] = (bf16_t)(cvt_pk_bf16(s, 0.f) & 0xffffu); } }
        }
#pragma unroll
        for (int jj = 0; jj < 4; ++jj) *(f32x4*)(So + (size_t)(p0 + jj) * 128 + n0) = hs[jj];
    }
}
__device__ __forceinline__ void mamba_post(const Params& p) {
    const bf16_t* Y = (const bf16_t*)(p.ws + WS_B3); const bf16_t* Z = (const bf16_t*)(p.ws + WS_B2); bf16_t* A2 = (bf16_t*)(p.ws + WS_B1);
    const int tid_ = tidx(), lane = tid_ & 63, gw = blockIdx.x * 8 + (tid_ >> 6), nw = gridDim.x * 8;
    for (int m = gw; m < NT; m += nw) {
        const size_t off = (size_t)m * 2048 + lane * 32;
        float v[32]; float ss = 0.f;
#pragma unroll
        for (int i = 0; i < 4; ++i) { const u32x4 y = *(const u32x4*)(Y + off + 8 * i), z = *(const u32x4*)(Z + off + 8 * i);
            v[8 * i + 0] = bflo(y.x) * bflo(z.x); v[8 * i + 1] = bfhi(y.x) * bfhi(z.x); v[8 * i + 2] = bflo(y.y) * bflo(z.y); v[8 * i + 3] = bfhi(y.y) * bfhi(z.y);
            v[8 * i + 4] = bflo(y.z) * bflo(z.z); v[8 * i + 5] = bfhi(y.z) * bfhi(z.z); v[8 * i + 6] = bflo(y.w) * bflo(z.w); v[8 * i + 7] = bfhi(y.w) * bfhi(z.w); }
#pragma unroll
        for (int i = 0; i < 32; ++i) ss += v[i] * v[i];
        ss = red16(ss);
        const float rstd = rsqrtf(ss * (1.0f / 512.0f) + NORM_EPS);
#pragma unroll
        for (int i = 0; i < 4; ++i) { const f32x4 g0 = ld4(p.in[39] + lane * 32 + 8 * i), g1 = ld4(p.in[39] + lane * 32 + 8 * i + 4); u32x4 o;
            o.x = cvt_pk_bf16(v[8 * i] * rstd * g0[0], v[8 * i + 1] * rstd * g0[1]); o.y = cvt_pk_bf16(v[8 * i + 2] * rstd * g0[2], v[8 * i + 3] * rstd * g0[3]);
            o.z = cvt_pk_bf16(v[8 * i + 4] * rstd * g1[0], v[8 * i + 5] * rstd * g1[1]); o.w = cvt_pk_bf16(v[8 * i + 6] * rstd * g1[2], v[8 * i + 7] * rstd * g1[3]);
            *(u32x4*)(A2 + off + 8 * i) = o; }
    }
}

__global__ void __launch_bounds__(512, 2) mega(Params p_unused) {
    extern __shared__ __attribute__((aligned(16))) unsigned char shm[];
    LAS unsigned char* lds = (LAS unsigned char*)shm;
    cg::grid_group grid = cg::this_grid();
#define SYNC() grid.sync()
#define WSP (getp().ws)
#define WBP ((bf16_t*)(getp().ws + WS_WB))
    convert_weights(getp(), (LAS float*)lds);
    { const Params& p = getp(); norm_phase(p, 0, p.in[7], true); }
    SYNC();
#pragma unroll 1
    for (int layer = 0; layer < 4; ++layer) {
        const int kind = layer % 3, j = layer / 3;
        const bf16_t* resA; const bf16_t* resB; int resK;
        if (kind == 0) {
            { const Params& p = getp(); unsigned char* B1 = p.ws + WS_B1;
              EpiArgs ea{B1, p.ws + WS_B2, B1 + (size_t)NT * 2048, B1 + (size_t)NT * 4096, p.in[14], nullptr, j};
              run_gemm<EP_HG_IN>(lds, (const bf16_t*)(p.ws + WS_B0), (const bf16_t*)(p.ws + WS_WB) + W_HGIN + j * W_HGIN_SZ, 1024, 16, false, ea); }
            SYNC();
            hgrn_scan(getp(), j, lds);
            SYNC();
            hgrn_post(getp(), j);
            resA = (const bf16_t*)(WSP + WS_B3 + 66 * MiB); resB = WBP + W_HGOUT + j * W_HGOUT_SZ; resK = 1024;
        } else if (kind == 1) {
            { const Params& p = getp();
              EpiArgs ea{p.ws + WS_B1, p.ws + WS_B3 + (size_t)NT * 4096, nullptr, nullptr, nullptr, nullptr, 0};
              run_gemm<EP_RW_IN>(lds, (const bf16_t*)(p.ws + WS_B0), (const bf16_t*)(p.ws + WS_WB) + W_RWIN, 2048, 13, false, ea); }
            SYNC();
            { const Params& p = getp(); unsigned char* B3 = p.ws + WS_B3;
              EpiArgs e2{p.ws + WS_B2, B3, B3 + (size_t)NT * 2048, nullptr, p.in[19], p.in[22], 0};
              run_gemm<EP_RW_L2>(lds, (const bf16_t*)(B3 + (size_t)NT * 4096), (const bf16_t*)(p.ws + WS_WB) + W_RWL2, 256, 12, false, e2); }
            SYNC();
            rwkv_scan(getp(), lds);
            SYNC();
            rwkv_post(getp());
            resA = (const bf16_t*)(WSP + WS_B2); resB = WBP + W_RWOUT; resK = 1024;
        } else {
            { const Params& p = getp();
              EpiArgs ea{p.ws + WS_B2, p.ws + WS_B1, p.ws + WS_B4, nullptr, p.in[36], nullptr, 0};
              run_gemm<EP_MB_IN>(lds, (const bf16_t*)(p.ws + WS_B0), (const bf16_t*)(p.ws + WS_WB) + W_MBIN, 1024, 21, false, ea); }
            SYNC();
            mamba_scan(getp(), lds);
            SYNC();
            mamba_post(getp());
            resA = (const bf16_t*)(WSP + WS_B1); resB = WBP + W_MBOUT; resK = 2048;
        }
        SYNC();
        { EpiArgs er{getp().out, nullptr, nullptr, nullptr, nullptr, nullptr, 0};
          run_gemm<EP_RES>(lds, resA, resB, resK, 4, true, er); }
        SYNC();
        { const Params& p = getp(); norm_phase(p, 0, p.in[8] + layer * 1024, false); }
        SYNC();
        { const Params& p = getp(); EpiArgs ea{p.ws + WS_B1, nullptr, nullptr, nullptr, nullptr, nullptr, 0};
          run_gemm<EP_FFN>(lds, (const bf16_t*)(p.ws + WS_B0), (const bf16_t*)(p.ws + WS_WB) + W_GU + layer * W_GU_SZ, 1024, 22, false, ea); }
        SYNC();
        { const Params& p = getp(); EpiArgs er{p.out, nullptr, nullptr, nullptr, nullptr, nullptr, 0};
          run_gemm<EP_RES>(lds, (const bf16_t*)(p.ws + WS_B1), (const bf16_t*)(p.ws + WS_WB) + W_D + layer * W_D_SZ, 2816, 4, true, er); }
        SYNC();
        { const Params& p = getp();
          if (layer < 3) norm_phase(p, ((layer + 1) % 3 == 1) ? 1 : 0, p.in[7] + (layer + 1) * 1024, false);
          else norm_phase(p, 2, p.in[9], false); }
        if (layer < 3) SYNC();
    }
}

extern "C" void kernel_launch(void* const* d_in, const int* in_sizes, int n_in, void* d_out, int out_size, void* d_ws, size_t ws_size, hipStream_t stream) {
    static int grid_blocks = 0;
    if (!grid_blocks) {
        int dev = 0, cus = 0, per_cu = 0;
        hipGetDevice(&dev);
        hipDeviceGetAttribute(&cus, hipDeviceAttributeMultiprocessorCount, dev);
        hipFuncSetAttribute((const void*)mega, hipFuncAttributeMaxDynamicSharedMemorySize, LDS_BYTES);
        hipOccupancyMaxActiveBlocksPerMultiprocessor(&per_cu, (const void*)mega, 512, LDS_BYTES);
        if (per_cu < 1) per_cu = 1;
        grid_blocks = cus * per_cu;
        if (ws_size < WS_END) fprintf(stderr, "kernel_launch: workspace too small: %zu < %zu\n", ws_size, (size_t)WS_END);
    }
    Params p{};
    for (int i = 0; i < 41; ++i) p.in[i] = (const float*)d_in[i];
    p.out = (float*)d_out; p.ws = (unsigned char*)d_ws;
    void* args[] = {&p};
    hipError_t e = hipLaunchCooperativeKernel((const void*)mega, dim3(grid_blocks), dim3(512), args, LDS_BYTES, stream);
    if (e != hipSuccess) fprintf(stderr, "cooperative launch failed: %s (grid %d)\n", hipGetErrorString(e), grid_blocks);
}
```

```cpp
#include <hip/hip_runtime.h>
#include <hip/hip_cooperative_groups.h>
#include <cstdio>
namespace cg = cooperative_groups;

#define LAS __attribute__((address_space(3)))
typedef unsigned short bf16_t;
typedef short bf16x8 __attribute__((ext_vector_type(8)));
typedef float f32x4 __attribute__((ext_vector_type(4)));
typedef float f32x2 __attribute__((ext_vector_type(2)));
typedef unsigned u32x4 __attribute__((ext_vector_type(4)));
typedef unsigned u32x2 __attribute__((ext_vector_type(2)));

constexpr int NT = 16896, NP = 16384, D = 1024, DFF = 2816;
constexpr float NORM_EPS = 1e-6f;
constexpr size_t O_HGP = 17301504, O_HGS = 19398656, O_WKVP = 52953088, O_WKVS = 53477376, O_SHP = 61865984, O_SHS = 61874176,
                 O_SSMP = 62005248, O_SSMS = 64102400, O_CVP = 97656832, O_CVS = 97730560;
constexpr size_t MiB = 1048576;
constexpr size_t WS_WB = 1 * MiB;
constexpr size_t W_GU = 0, W_GU_SZ = (size_t)5632 * 1024, W_D = W_GU + 4 * W_GU_SZ, W_D_SZ = (size_t)1024 * 2816, W_HGIN = W_D + 4 * W_D_SZ, W_HGIN_SZ = (size_t)4096 * 1024,
                 W_HGOUT = W_HGIN + 2 * W_HGIN_SZ, W_HGOUT_SZ = (size_t)1024 * 1024, W_RWIN = W_HGOUT + 2 * W_HGOUT_SZ, W_RWL2 = W_RWIN + (size_t)3328 * 2048,
                 W_RWOUT = W_RWL2 + (size_t)3072 * 256, W_MBIN = W_RWOUT + (size_t)1024 * 1024, W_MBOUT = W_MBIN + (size_t)5376 * 1024, W_END = W_MBOUT + (size_t)1024 * 2048;
static_assert(W_END * 2 <= 117 * MiB, "weights");
constexpr size_t WS_B0 = 119 * MiB, WS_B1 = WS_B0 + 66 * MiB, WS_B2 = WS_B1 + 99 * MiB, WS_B3 = WS_B2 + 66 * MiB, WS_B4 = WS_B3 + 99 * MiB, WS_END = WS_B4 + 3 * MiB;
constexpr int LDS_BYTES = 147456;

struct Params { const float* in[41]; float* out; unsigned char* ws; };
typedef const Params __attribute__((address_space(4))) * KParams;
__device__ __forceinline__ const Params& getp() { KParams k = (KParams)__builtin_amdgcn_kernarg_segment_ptr(); asm volatile("" : "+s"(k)); return *(const Params*)k; }

__device__ __forceinline__ int tidx() { int t = threadIdx.x; asm volatile("" : "+v"(t)); return t; }
__device__ __forceinline__ unsigned cvt_pk_bf16(float lo, float hi) { unsigned r; asm volatile("v_cvt_pk_bf16_f32 %0, %1, %2" : "=v"(r) : "v"(lo), "v"(hi)); return r; }
__device__ __forceinline__ float bflo(unsigned w) { return __uint_as_float(w << 16); }
__device__ __forceinline__ float bfhi(unsigned w) { return __uint_as_float(w & 0xffff0000u); }
__device__ __forceinline__ float sigmoidf_(float x) { return 1.0f / (1.0f + __expf(-x)); }
__device__ __forceinline__ float siluf_(float x) { return x * sigmoidf_(x); }
__device__ __forceinline__ float softplusf_(float x) { return fmaxf(x, 0.f) + log1pf(__expf(-fabsf(x))); }
template <int CTRL> __device__ __forceinline__ float dppf(float x) { return __int_as_float(__builtin_amdgcn_update_dpp(0, __float_as_int(x), CTRL, 0xf, 0xf, true)); }
__device__ __forceinline__ float red4(float x) { x += dppf<0xB1>(x); x += dppf<0x4E>(x); return x; }
__device__ __forceinline__ float red8(float x) { x = red4(x); x += dppf<0x141>(x); return x; }
__device__ __forceinline__ float red16(float x) { x = red8(x); x += dppf<0x140>(x); return x; }
__device__ __forceinline__ float red64(float x) { x = red16(x); x += __shfl_xor(x, 16); x += __shfl_xor(x, 32); return x; }
__device__ __forceinline__ f32x4 ld4(const float* p) { return *(const f32x4*)p; }

#define XB_TMO      128
#define XB_XCNT(j)  (256  + 64 * (j))
#define XB_XSUB(j)  (1280 + 64 * (j))
#define XB_XGEN(j)  (2304 + 64 * (j))
#define XB_TOP      3328
#define XB_TOPGEN   3392
#define XCD_BAR_WORDS 3456
#define XB_SPIN_CAP (1u << 18)
__device__ __forceinline__ unsigned xb_ld(unsigned* p)              { return __hip_atomic_load(p, __ATOMIC_RELAXED, __HIP_MEMORY_SCOPE_AGENT); }
__device__ __forceinline__ unsigned xb_add(unsigned* p, unsigned v) { return __hip_atomic_fetch_add(p, v, __ATOMIC_RELAXED, __HIP_MEMORY_SCOPE_AGENT); }
__device__ __forceinline__ unsigned xb_xcc_id() { return (unsigned)__builtin_amdgcn_s_getreg((3 << 11) | 20) & 0xFu; }
#define XB_SPIN(cond, bar) do { unsigned _sp = 0; while (cond) { __builtin_amdgcn_s_sleep(1); \
    if ((++_sp & 255u) == 0u) { if (xb_ld(&(bar)[XB_TMO])) break; if (_sp > XB_SPIN_CAP) { atomicAdd(&(bar)[XB_TMO], 1u); break; } } } } while (0)
struct XcdBarrier { unsigned* bar; unsigned x; volatile LAS unsigned* st; };
__device__ __forceinline__ XcdBarrier xcd_barrier_post(unsigned* bar, volatile LAS unsigned* st) {
    XcdBarrier b; b.bar = bar; b.x = xb_xcc_id(); b.st = st;
    if (threadIdx.x == 0) (void)xb_add(&bar[XB_XCNT(b.x)], 1u);
    return b;
}
__device__ __forceinline__ void xcd_barrier_complete(unsigned* bar, unsigned x, unsigned& nloc, unsigned& nx) {
    const unsigned G = gridDim.x * gridDim.y * gridDim.z;
    unsigned sum, cnt, mine, sp = 0u;
    for (;;) {
        sum = 0u; cnt = 0u; mine = 0u;
#pragma unroll
        for (unsigned j = 0; j < 16; ++j) { const unsigned c = xb_ld(&bar[XB_XCNT(j)]); sum += c; cnt += (c > 0u) ? 1u : 0u; mine = (j == x) ? c : mine; }
        if (sum == G) break;
        __builtin_amdgcn_s_sleep(1);
        if ((++sp & 255u) == 0u) { if (xb_ld(&bar[XB_TMO])) break; if (sp > XB_SPIN_CAP) { atomicAdd(&bar[XB_TMO], 1u); break; } }
    }
    nloc = mine > 0u ? mine : 1u; nx = cnt > 0u ? cnt : 1u;
}
__device__ __forceinline__ void xcd_barrier(const XcdBarrier& b) {
    asm volatile("s_waitcnt vmcnt(0)" ::: "memory");
    __syncthreads();
    if (threadIdx.x == 0) {
        unsigned* bar = b.bar;
        __builtin_amdgcn_s_waitcnt(0);
        unsigned nloc = b.st[0], nx = b.st[1];
        if (nloc == 0u) { xcd_barrier_complete(bar, b.x, nloc, nx); b.st[0] = nloc; b.st[1] = nx; }
        const unsigned old = xb_add(&bar[XB_XSUB(b.x)], 1u);
        const unsigned gen = old / nloc;
        if (old + 1u == (gen + 1u) * nloc) {
            __builtin_amdgcn_fence(__ATOMIC_RELEASE, "agent");
            asm volatile("s_waitcnt vmcnt(0)" ::: "memory");
            const unsigned og = xb_add(&bar[XB_TOP], 1u);
            const unsigned tg = og / nx;
            if (og + 1u == (tg + 1u) * nx) xb_add(&bar[XB_TOPGEN], 1u);
            else XB_SPIN(xb_ld(&bar[XB_TOPGEN]) == tg, bar);
            __builtin_amdgcn_fence(__ATOMIC_ACQUIRE, "agent");
            xb_add(&bar[XB_XGEN(b.x)], 1u);
            asm volatile("s_waitcnt vmcnt(0)" ::: "memory");
        } else {
            XB_SPIN(xb_ld(&bar[XB_XGEN(b.x)]) == gen, bar);
            __builtin_amdgcn_fence(__ATOMIC_ACQUIRE, "agent");
            asm volatile("s_waitcnt vmcnt(0)" ::: "memory");
        }
    }
    __syncthreads();
}

namespace pg8 {
constexpr int BM = 256, BK = 64, HALF = 128, HTB = HALF * BK * 2, NXCD = 8, WGM = 8;
__device__ __forceinline__ int lds_byte(int r, int c) { const int st = (r >> 4) * 2 + (c >> 5), rr = r & 15, cc = c & 31, ob = rr * 64 + cc * 2; return st * 1024 + (ob ^ (((ob >> 9) & 1) << 5)); }
__device__ __forceinline__ void stage_rc(int b, int& R, int& C) { const int st = b / 1024, sb = b % 1024, swz = sb ^ (((sb >> 9) & 1) << 5); R = (st >> 1) * 16 + swz / 64; C = (st & 1) * 32 + (swz % 64) / 2; }
struct Unit { int pm, pn, k0, nt, split; };
struct Gemm { const bf16_t* A; const bf16_t* Bt; int K; };
struct Sched {
    int nM, nN, nwg, G, c, ntF, nTail, tailPm0, tbase;
    __device__ __forceinline__ void init(int nM_, int nN_, int G_, int c_, int K, int tailRows  ) {
        nM = nM_; nN = nN_; nwg = nM * nN; G = G_; c = c_; ntF = K / BK; tbase = tailRows * nN; nTail = tbase * (K / 256); tailPm0 = nM_;
    }
    __device__ __forceinline__ bool next(int i, Unit& u) const {
        long L = (long)i * G + c;
        if (L < nwg) {
            int wgid = (int)L; { const int q = nwg / NXCD, r = nwg % NXCD, xcd = wgid % NXCD, off = wgid / NXCD; wgid = (xcd < r ? xcd * (q + 1) : r * (q + 1) + (xcd - r) * q) + off; }
            const int nig = WGM * nN, gid = wgid / nig, fm = gid * WGM, gsz = (nM - fm) < WGM ? (nM - fm) : WGM;
            u.pm = fm + ((wgid % nig) % gsz); u.pn = (wgid % nig) / gsz; u.k0 = 0; u.nt = ntF; u.split = 0; return true;
        }
        L -= nwg;
        if (L >= nTail) return false;
        const int ub = (int)L % tbase, s = (int)L / tbase;
        u.pm = tailPm0 + ub / nN; u.pn = ub % nN; u.k0 = s * 256; u.nt = 4; u.split = 1; return true;
    }
};

template <class Epi>
__device__ __forceinline__ void gemm_phase(LAS unsigned char* lds, const Gemm g, const Sched& S, const Epi& E) {
    const int tid = tidx(), wid = __builtin_amdgcn_readfirstlane(tid >> 6), lane = tid & 63, wr = wid >> 2, wc = wid & 3, fr = lane & 15, fq = lane >> 4;
    const int K = g.K;
    unsigned voffA[2];
#pragma unroll
    for (int i = 0; i < 2; ++i) { int R, C; stage_rc(tid * 16 + i * 8192, R, C); voffA[i] = (unsigned)(R * K + C) * 2u; }
    const size_t kstep = (size_t)(BK * 2);
    const size_t hstep = (size_t)HALF * K * 2;
    const size_t tstep = 2 * hstep;
    const unsigned ldsw = (unsigned)wid * 1024u;
    const int aoff = lds_byte(wr * 64 + fr, fq * 8), boff = lds_byte(wc * 32 + fr, fq * 8);
#define PG8_SA(b, h) (((b) * 2 + (h)) * HTB)
#define PG8_SB(b, h) ((4 + (b) * 2 + (h)) * HTB)
#define PG8_STAGE(bufoff, gbase, voff) do { _Pragma("unroll") for (int _i = 0; _i < 2; ++_i) \
        __builtin_amdgcn_global_load_lds((const unsigned*)((const char*)(gbase) + (voff)[_i]), (LAS unsigned*)(lds + (bufoff) + ldsw + _i * 8192), 16, 0, 0); } while (0)
#define PG8_LDA(dst, b, h) do { _Pragma("unroll") for (int m = 0; m < 4; ++m) _Pragma("unroll") for (int k = 0; k < 2; ++k) dst[m][k] = *(const LAS bf16x8*)(lds + PG8_SA(b, h) + aoff + m * 2048 + k * 1024); } while (0)
#define PG8_LDB(dst, b, h) do { _Pragma("unroll") for (int n = 0; n < 2; ++n) _Pragma("unroll") for (int k = 0; k < 2; ++k) dst[n][k] = *(const LAS bf16x8*)(lds + PG8_SB(b, h) + boff + n * 2048 + k * 1024); } while (0)
#define PG8_MMA(ai, bj, At, Bt) do { __builtin_amdgcn_s_setprio(1); _Pragma("unroll") for (int m = 0; m < 4; ++m) _Pragma("unroll") for (int n = 0; n < 2; ++n) _Pragma("unroll") for (int k = 0; k < 2; ++k) \
        acc[ai][bj][m][n] = __builtin_amdgcn_mfma_f32_16x16x32_bf16(Bt[n][k], At[m][k], acc[ai][bj][m][n], 0, 0, 0); __builtin_amdgcn_s_setprio(0); } while (0)
#define PG8_WAIT_V(n) asm volatile("s_waitcnt vmcnt(" #n ")" ::: "memory")
#define PG8_WAIT_L(n) asm volatile("s_waitcnt lgkmcnt(" #n ")" ::: "memory")
#define PG8_BAR __builtin_amdgcn_s_barrier()
#define PG8_SCHED __builtin_amdgcn_sched_barrier(0)
    Unit cur, nxt; int ui = 0;
    if (!S.next(0, cur)) return;
    f32x4 acc[2][2][4][2];
#pragma unroll
    for (int a = 0; a < 2; ++a)
#pragma unroll
        for (int b = 0; b < 2; ++b)
#pragma unroll
            for (int m = 0; m < 4; ++m)
#pragma unroll
                for (int n = 0; n < 2; ++n) acc[a][b][m][n] = (f32x4){0.f, 0.f, 0.f, 0.f};
    bf16x8 At[4][2], B0[2][2], B1[2][2];
    const char* cA = (const char*)g.A + (size_t)cur.pm * tstep + (size_t)cur.k0 * 2; const char* cB = (const char*)g.Bt + (size_t)cur.pn * tstep + (size_t)cur.k0 * 2;
    int nt = cur.nt;
    PG8_STAGE(PG8_SB(0, 0), cB, voffA); PG8_STAGE(PG8_SA(0, 0), cA, voffA); PG8_STAGE(PG8_SB(0, 1), cB + hstep, voffA); PG8_STAGE(PG8_SA(0, 1), cA + hstep, voffA);
    if (wr == 1) PG8_BAR;
    PG8_WAIT_V(4); PG8_BAR;
    PG8_STAGE(PG8_SB(1, 0), cB + kstep, voffA); PG8_STAGE(PG8_SA(1, 0), cA + kstep, voffA); PG8_STAGE(PG8_SB(1, 1), cB + hstep + kstep, voffA);
    PG8_WAIT_V(6); PG8_BAR;
    for (;;) {
        const bool has_next = S.next(ui + 1, nxt);
        const char* nA = has_next ? (const char*)g.A + (size_t)nxt.pm * tstep + (size_t)nxt.k0 * 2 : cA; const char* nB = has_next ? (const char*)g.Bt + (size_t)nxt.pn * tstep + (size_t)nxt.k0 * 2 : cB;
        for (int t = 0; t < nt; t += 2) {
            const bool last = (t == nt - 2);
            const char* a1 = cA + (size_t)(t + 1) * kstep;
            const char* a2 = last ? nA : cA + (size_t)(t + 2) * kstep; const char* b2 = last ? nB : cB + (size_t)(t + 2) * kstep;
            const char* a3 = a2 + kstep; const char* b3 = b2 + kstep;
            PG8_LDB(B0, 0, 0); PG8_SCHED; PG8_LDA(At, 0, 0); PG8_STAGE(PG8_SA(1, 1), a1 + hstep, voffA);
            PG8_WAIT_L(8); PG8_BAR; PG8_WAIT_L(0); PG8_MMA(0, 0, At, B0); PG8_BAR; PG8_SCHED;
            PG8_LDB(B1, 0, 1); PG8_STAGE(PG8_SB(0, 0), b2, voffA);
            PG8_BAR; PG8_WAIT_L(0); PG8_MMA(0, 1, At, B1); PG8_BAR;
            PG8_LDA(At, 0, 1); PG8_STAGE(PG8_SA(0, 0), a2, voffA);
            PG8_BAR; PG8_WAIT_L(0); PG8_MMA(1, 0, At, B0); PG8_BAR; PG8_SCHED;
            PG8_STAGE(PG8_SB(0, 1), b2 + hstep, voffA);
            PG8_WAIT_V(6); PG8_BAR; PG8_MMA(1, 1, At, B1); PG8_BAR;
            PG8_LDB(B0, 1, 0); PG8_SCHED; PG8_LDA(At, 1, 0); PG8_STAGE(PG8_SA(0, 1), a2 + hstep, voffA);
            PG8_WAIT_L(8); PG8_BAR; PG8_WAIT_L(0); PG8_MMA(0, 0, At, B0); PG8_BAR; PG8_SCHED;
            PG8_LDB(B1, 1, 1); PG8_STAGE(PG8_SB(1, 0), b3, voffA);
            PG8_BAR; PG8_WAIT_L(0); PG8_MMA(0, 1, At, B1); PG8_BAR;
            PG8_LDA(At, 1, 1); PG8_STAGE(PG8_SA(1, 0), a3, voffA);
            PG8_BAR; PG8_WAIT_L(0); PG8_MMA(1, 0, At, B0); PG8_BAR; PG8_SCHED;
            PG8_STAGE(PG8_SB(1, 1), b3 + hstep, voffA);
            PG8_WAIT_V(6); PG8_BAR; PG8_MMA(1, 1, At, B1); PG8_BAR;
        }
        E(acc, cur, wr, wc, fr, fq);
        if (!has_next) break;
#pragma unroll
        for (int a = 0; a < 2; ++a)
#pragma unroll
            for (int b = 0; b < 2; ++b)
#pragma unroll
                for (int m = 0; m < 4; ++m)
#pragma unroll
                    for (int n = 0; n < 2; ++n) acc[a][b][m][n] = (f32x4){0.f, 0.f, 0.f, 0.f};
        cur = nxt; cA = nA; cB = nB; nt = cur.nt; ++ui;
    }
    PG8_WAIT_V(0);
    if (wr == 0) PG8_BAR;
    PG8_BAR;
#undef PG8_SA
#undef PG8_SB
#undef PG8_STAGE
#undef PG8_LDA
#undef PG8_LDB
#undef PG8_MMA
#undef PG8_WAIT_V
#undef PG8_WAIT_L
#undef PG8_BAR
#undef PG8_SCHED
}
}

enum { EP_HG_IN = 0, EP_RW_IN, EP_RW_L2, EP_MB_IN, EP_RES, EP_FFN };
struct EpiArgs { void* p0; void* p1; void* p2; void* p3; const float* c0; const float* c1; int j; };
template <int MODE> struct Epi {
    EpiArgs a;
    __device__ __forceinline__ void st_bf4(bf16_t* p, f32x4 v) const { u32x2 w; w.x = cvt_pk_bf16(v[0], v[1]); w.y = cvt_pk_bf16(v[2], v[3]); *(u32x2*)p = w; }
    __device__ __forceinline__ void emit(int row, int col, f32x4 v, const pg8::Unit& u) const {
        if constexpr (MODE == EP_HG_IN) {
            const int seg = u.pn >> 2, cs = col & 1023;
            if (seg == 0) { f32x4 o; for (int i = 0; i < 4; ++i) o[i] = siluf_(v[i]); st_bf4((bf16_t*)a.p0 + (size_t)row * 1024 + cs, o); }
            else if (seg == 1) {
                f32x4 o;
                if (a.j) { const f32x4 l0 = ld4(a.c0 + cs), l1 = ld4(a.c0 + 1024 + cs);
                    for (int i = 0; i < 4; ++i) { const float lb = 1.0f / (1.0f + __expf(l0[i] - l1[i])); o[i] = lb + (1.0f - lb) * sigmoidf_(v[i]); } }
                else { for (int i = 0; i < 4; ++i) o[i] = sigmoidf_(v[i]); }
                *(f32x4*)((float*)a.p1 + (size_t)row * 1024 + cs) = o; }
            else if (seg == 2) { st_bf4((bf16_t*)a.p2 + (size_t)row * 1024 + cs, v); }
            else { f32x4 o; for (int i = 0; i < 4; ++i) o[i] = siluf_(v[i]); st_bf4((bf16_t*)a.p3 + (size_t)row * 1024 + cs, o); }
        } else if constexpr (MODE == EP_RW_IN) {
            if (u.pn < 12) st_bf4((bf16_t*)a.p0 + (size_t)row * 3072 + col, v);
            else { const int cs = col - 3072; f32x4 o;
                if (cs < 64) { for (int i = 0; i < 4; ++i) o[i] = tanhf(v[i]); } else if (cs < 128) o = v; else { for (int i = 0; i < 4; ++i) o[i] = sigmoidf_(v[i]); }
                st_bf4((bf16_t*)a.p1 + (size_t)row * 256 + cs, o); }
        } else if constexpr (MODE == EP_RW_L2) {
            const int seg = u.pn >> 2, cs = col & 1023;
            if (seg == 0) { const f32x4 w0 = ld4(a.c0 + cs); f32x4 o;
                for (int i = 0; i < 4; ++i) { const float wl = -softplusf_(-(w0[i] + v[i])) - 0.5f; o[i] = __expf(-__expf(wl)); }
                *(f32x4*)((float*)a.p0 + (size_t)row * 1024 + cs) = o; }
            else if (seg == 1) { const f32x4 a0 = ld4(a.c1 + cs); f32x4 o; for (int i = 0; i < 4; ++i) o[i] = sigmoidf_(a0[i] + v[i]); st_bf4((bf16_t*)a.p1 + (size_t)row * 1024 + cs, o); }
            else st_bf4((bf16_t*)a.p2 + (size_t)row * 1024 + cs, v);
        } else if constexpr (MODE == EP_MB_IN) {
            if (u.pn < 8) { f32x4 o; for (int i = 0; i < 4; ++i) o[i] = siluf_(v[i]); st_bf4((bf16_t*)a.p0 + (size_t)row * 2048 + col, o); }
            else if (u.pn < 20) st_bf4((bf16_t*)a.p1 + (size_t)row * 3072 + (col - 2048), v);
            else { const int cs = col - 5120; if (cs < 32) { const f32x4 b = ld4(a.c0 + cs); f32x4 o; for (int i = 0; i < 4; ++i) o[i] = softplusf_(v[i] + b[i]); *(f32x4*)((float*)a.p2 + (size_t)row * 32 + cs) = o; } }
        } else if constexpr (MODE == EP_RES) {
            float* x = (float*)a.p0 + (size_t)row * 1024 + col;
            if (u.split) { for (int i = 0; i < 4; ++i) unsafeAtomicAdd(x + i, v[i]); }
            else { f32x4 o = *(f32x4*)x; o += v; *(f32x4*)x = o; }
        }
    }
    __device__ __forceinline__ void operator()(const f32x4 (&acc)[2][2][4][2], const pg8::Unit& u, int wr, int wc, int fr, int fq) const {
        const int row0 = u.pm * 256 + wr * 64 + fr;
        if constexpr (MODE == EP_FFN) {
            bf16_t* act = (bf16_t*)a.p0;
#pragma unroll
            for (int ai = 0; ai < 2; ++ai)
#pragma unroll
                for (int m = 0; m < 4; ++m) { const int row = row0 + ai * 128 + m * 16;
#pragma unroll
                    for (int n = 0; n < 2; ++n) { const int j = u.pn * 128 + wc * 32 + n * 16 + 4 * fq; const f32x4 g = acc[ai][0][m][n], up = acc[ai][1][m][n]; f32x4 o;
                        for (int i = 0; i < 4; ++i) o[i] = siluf_(g[i]) * up[i];
                        st_bf4(act + (size_t)row * DFF + j, o); } }
        } else {
#pragma unroll
            for (int ai = 0; ai < 2; ++ai)
#pragma unroll
                for (int m = 0; m < 4; ++m) { const int row = row0 + ai * 128 + m * 16;
#pragma unroll
                    for (int bj = 0; bj < 2; ++bj)
#pragma unroll
                        for (int n = 0; n < 2; ++n) emit(row, u.pn * 256 + bj * 128 + wc * 32 + n * 16 + 4 * fq, acc[ai][bj][m][n], u); }
        }
    }
};

template <int MODE>
__device__ __forceinline__ void run_gemm(LAS unsigned char* lds, const bf16_t* A, const bf16_t* Bt, int K, int nN, bool resid, const EpiArgs& ea) {
    pg8::Gemm g{A, Bt, K}; pg8::Sched S;
    if (resid) S.init(64, nN, (int)gridDim.x, (int)blockIdx.x, K, 2); else { S.init(66, nN, (int)gridDim.x, (int)blockIdx.x, K, 0); }
    Epi<MODE> E{ea};
    pg8::gemm_phase<Epi<MODE>>(lds, g, S, E);
}

struct Job { const float* src; int Ks, Ns; bf16_t* dst; int ldd, coloff, rowmode, rowoff; const float* mu; int mumode; };
__device__ __forceinline__ void get_job(int j, const Params& p, bf16_t* WB, Job& J) {
    J.coloff = 0; J.rowmode = 0; J.rowoff = 0; J.mu = nullptr; J.mumode = 0;
    if (j < 12) { const int l = j / 3, t = j % 3;
        if (t == 0) { J.src = p.in[10] + (size_t)l * 1024 * 2816; J.Ks = 1024; J.Ns = 2816; J.dst = WB + W_GU + l * W_GU_SZ; J.ldd = 1024; J.rowmode = 1; }
        else if (t == 1) { J.src = p.in[11] + (size_t)l * 1024 * 2816; J.Ks = 1024; J.Ns = 2816; J.dst = WB + W_GU + l * W_GU_SZ; J.ldd = 1024; J.rowmode = 1; J.rowoff = 128; }
        else { J.src = p.in[12] + (size_t)l * 2816 * 1024; J.Ks = 2816; J.Ns = 1024; J.dst = WB + W_D + l * W_D_SZ; J.ldd = 2816; }
    } else if (j < 16) { const int q = j - 12, jj = q >> 1;
        if ((q & 1) == 0) { J.src = p.in[13] + (size_t)jj * 1024 * 4096; J.Ks = 1024; J.Ns = 4096; J.dst = WB + W_HGIN + jj * W_HGIN_SZ; J.ldd = 1024; }
        else { J.src = p.in[16] + (size_t)jj * 1024 * 1024; J.Ks = 1024; J.Ns = 1024; J.dst = WB + W_HGOUT + jj * W_HGOUT_SZ; J.ldd = 1024; }
    } else if (j < 28) { const int q = j - 16, s = q >> 1, half = q & 1;
        J.Ks = 1024; J.ldd = 2048; J.dst = WB + W_RWIN; J.coloff = half * 1024; J.mu = p.in[17] + s * 1024; J.mumode = 1 + half;
        if (s < 3) { J.src = p.in[18] + (size_t)s * 1024 * 1024; J.Ns = 1024; J.rowoff = 1024 * s; }
        else if (s == 3) { J.src = p.in[20]; J.Ns = 64; J.rowoff = 3072; }
        else if (s == 4) { J.src = p.in[23]; J.Ns = 64; J.rowoff = 3136; }
        else { J.src = p.in[25]; J.Ns = 128; J.rowoff = 3200; }
    } else if (j == 28) { J.src = p.in[32]; J.Ks = 1024; J.Ns = 1024; J.dst = WB + W_RWOUT; J.ldd = 1024; }
    else if (j == 29) { J.src = p.in[33]; J.Ks = 1024; J.Ns = 5152; J.dst = WB + W_MBIN; J.ldd = 1024; }
    else { J.src = p.in[40]; J.Ks = 2048; J.Ns = 1024; J.dst = WB + W_MBOUT; J.ldd = 2048; }
}
__device__ __forceinline__ void convert_weights(const Params& p, LAS float* tl  ) {
    bf16_t* WB = (bf16_t*)(p.ws + WS_WB);
    const int tid = tidx(), G = gridDim.x;
    int base = 0;
    for (int j = 0; j < 31; ++j) {
        Job J; get_job(j, p, WB, J);
        const int tk = J.Ks / 64, tn = (J.Ns + 63) / 64, ntile = tk * tn;
        int first = ((int)blockIdx.x - base % G + G) % G;
        for (int t = first; t < ntile; t += G) {
            const int k0 = (t / tn) * 64, n0 = (t % tn) * 64;
            __syncthreads();
#pragma unroll
            for (int r = 0; r < 2; ++r) { const int kk = (tid >> 4) + 32 * r, n4 = (tid & 15) * 4;
                f32x4 v = (f32x4){0.f, 0.f, 0.f, 0.f};
                if (n0 + n4 < J.Ns) v = ld4(J.src + (size_t)(k0 + kk) * J.Ns + n0 + n4);
                if (J.mumode) { const float m = J.mu[k0 + kk]; const float s = (J.mumode == 1) ? (1.0f - m) : m; v *= s; }
                tl[kk * 65 + n4] = v[0]; tl[kk * 65 + n4 + 1] = v[1]; tl[kk * 65 + n4 + 2] = v[2]; tl[kk * 65 + n4 + 3] = v[3]; }
            __syncthreads();
            const int n = tid >> 3, k8 = (tid & 7) * 8;
            if (n0 + n < J.Ns) {
                float f[8];
#pragma unroll
                for (int i = 0; i < 8; ++i) f[i] = tl[(k8 + i) * 65 + n];
                u32x4 w; w.x = cvt_pk_bf16(f[0], f[1]); w.y = cvt_pk_bf16(f[2], f[3]); w.z = cvt_pk_bf16(f[4], f[5]); w.w = cvt_pk_bf16(f[6], f[7]);
                const int ns = n0 + n; const int drow = (J.rowmode ? ((ns >> 7) * 256 + (ns & 127)) : ns) + J.rowoff;
                *(u32x4*)(J.dst + (size_t)drow * J.ldd + J.coloff + k0 + k8) = w;
            }
        }
        base += ntile;
    }
    const size_t gt = (size_t)blockIdx.x * 512 + tid, gs = (size_t)G * 512;
    bf16_t* L2 = WB + W_RWL2;
    for (size_t i = gt; i < (size_t)3072 * 256; i += gs) { const int n = (int)(i % 3072), c = (int)(i / 3072), s = n >> 10, d = n & 1023; float v = 0.f;
        if (s == 0 && c < 64) v = p.in[21][(size_t)c * 1024 + d]; else if (s == 1 && c >= 64 && c < 128) v = p.in[24][(size_t)(c - 64) * 1024 + d]; else if (s == 2 && c >= 128) v = p.in[26][(size_t)(c - 128) * 1024 + d];
        L2[(size_t)n * 256 + c] = (bf16_t)(cvt_pk_bf16(v, 0.f) & 0xffffu); }
    unsigned* zp = (unsigned*)(WB + W_MBIN + (size_t)5152 * 1024);
    for (size_t i = gt; i < (size_t)224 * 1024 / 2; i += gs) zp[i] = 0u;
}

__device__ __forceinline__ void norm_phase(const Params& p, int mode, const float* gvec, bool from_input) {
    const int tid_ = tidx(), lane = tid_ & 63, gw = blockIdx.x * 8 + (tid_ >> 6), nw = gridDim.x * 8;
    float* X = p.out; bf16_t* A1 = (bf16_t*)(p.ws + WS_B0);
    f32x4 g[4];
#pragma unroll
    for (int i = 0; i < 4; ++i) g[i] = ld4(gvec + 4 * (lane + 64 * i));
    for (int m = gw; m < NT; m += nw) {
        const float* src = from_input ? (m < NP ? p.in[0] + (size_t)m * D : p.in[1] + (size_t)(m - NP) * D) : X + (size_t)m * D;
        f32x4 v[4]; float ss = 0.f;
#pragma unroll
        for (int i = 0; i < 4; ++i) { v[i] = ld4(src + 4 * (lane + 64 * i)); ss += v[i][0] * v[i][0] + v[i][1] * v[i][1] + v[i][2] * v[i][2] + v[i][3] * v[i][3]; }
        ss = red64(ss);
        const float rstd = rsqrtf(ss * (1.0f / 1024.0f) + NORM_EPS);
        if (from_input) {
#pragma unroll
            for (int i = 0; i < 4; ++i) *(f32x4*)(X + (size_t)m * D + 4 * (lane + 64 * i)) = v[i]; }
#pragma unroll
        for (int i = 0; i < 4; ++i) v[i] = v[i] * rstd * g[i];
        if (mode == 2) {
#pragma unroll
            for (int i = 0; i < 4; ++i) *(f32x4*)(X + (size_t)m * D + 4 * (lane + 64 * i)) = v[i];
        } else if (mode == 0) {
#pragma unroll
            for (int i = 0; i < 4; ++i) { u32x2 w; w.x = cvt_pk_bf16(v[i][0], v[i][1]); w.y = cvt_pk_bf16(v[i][2], v[i][3]); *(u32x2*)(A1 + (size_t)m * 1024 + 4 * (lane + 64 * i)) = w; }
        } else {
            const bool pr = m < NP; const int t = pr ? (m & 2047) : ((m - NP) & 3); const int T = pr ? 2048 : 4; const int b = pr ? (m >> 11) : ((m - NP) >> 2);
            const bool last = (t == T - 1), first = (t == 0);
#pragma unroll
            for (int i = 0; i < 4; ++i) { const int c = 4 * (lane + 64 * i); u32x2 w; w.x = cvt_pk_bf16(v[i][0], v[i][1]); w.y = cvt_pk_bf16(v[i][2], v[i][3]);
                *(u32x2*)(A1 + (size_t)m * 2048 + c) = w;
                if (!last) *(u32x2*)(A1 + (size_t)(m + 1) * 2048 + 1024 + c) = w;
                else *(f32x4*)(p.out + (pr ? O_SHP : O_SHS) + (size_t)b * 1024 + c) = v[i];
                if (first) { u32x2 z; z.x = 0u; z.y = 0u; if (!pr) { const f32x4 s = ld4(p.in[4] + (size_t)b * 1024 + c); z.x = cvt_pk_bf16(s[0], s[1]); z.y = cvt_pk_bf16(s[2], s[3]); }
                    *(u32x2*)(A1 + (size_t)m * 2048 + 1024 + c) = z; } }
        }
    }
}

__device__ __forceinline__ void hgrn_scan(const Params& p, int j, LAS unsigned char* lds) {
    const bf16_t* Q = (const bf16_t*)(p.ws + WS_B1); const bf16_t* V = Q + (size_t)NT * 1024; const float* F = (const float*)(p.ws + WS_B2); float* O = (float*)(p.ws + WS_B3);
    LAS float* f_s = (LAS float*)lds; LAS float* q_s = f_s + 32 * 128; LAS float* v_s = q_s + 32 * 128; LAS float* op_s = v_s + 32 * 32;
    const int tid = tidx(), w = tid >> 6, l = tid & 63, vloc = l & 31, kg = w * 2 + (l >> 5);
    for (int task = blockIdx.x; task < 256 + 4096; task += gridDim.x) {
        int b, h, qv, T, row0; const float* S0; float* So;
        if (task < 256) { b = task >> 5; h = (task >> 2) & 7; qv = task & 3; T = 2048; row0 = b * 2048; S0 = nullptr; So = p.out + O_HGP + ((size_t)(j * 8 + b) * 8 + h) * 16384; }
        else { const int u = task - 256; b = u >> 5; h = (u >> 2) & 7; qv = u & 3; T = 4; row0 = NP + b * 4; S0 = p.in[2] + ((size_t)(j * 128 + b) * 8 + h) * 16384; So = p.out + O_HGS + ((size_t)(j * 128 + b) * 8 + h) * 16384; }
        const int col0 = h * 128, vc = qv * 32 + vloc;
        float S[8];
#pragma unroll
        for (int i = 0; i < 8; ++i) S[i] = S0 ? S0[(size_t)(kg * 8 + i) * 128 + vc] : 0.f;
        const int nb = (T + 31) >> 5;
        f32x4 pf[2]; u32x4 pq, pv;
        auto loadb = [&](int bt) {
            const int t0 = bt * 32, ntok = min(32, T - t0);
#pragma unroll
            for (int r = 0; r < 2; ++r) { const int idx = tid + 512 * r, tok = idx >> 5, c4 = idx & 31; if (tok < ntok) pf[r] = ld4(F + (size_t)(row0 + t0 + tok) * 1024 + col0 + c4 * 4); }
            { const int tok = tid >> 4, c8 = tid & 15; if (tok < ntok) pq = *(const u32x4*)(Q + (size_t)(row0 + t0 + tok) * 1024 + col0 + c8 * 8); }
            if (tid < 128) { const int tok = tid >> 2, c8 = tid & 3; if (tok < ntok) pv = *(const u32x4*)(V + (size_t)(row0 + t0 + tok) * 1024 + col0 + qv * 32 + c8 * 8); }
        };
        loadb(0);
        for (int bt = 0; bt < nb; ++bt) {
            const int t0 = bt * 32, ntok = min(32, T - t0);
            __syncthreads();
#pragma unroll
            for (int r = 0; r < 2; ++r) { const int idx = tid + 512 * r, tok = idx >> 5, c4 = idx & 31; if (tok < ntok) *(LAS f32x4*)(f_s + tok * 128 + c4 * 4) = pf[r]; }
            { const int tok = tid >> 4, c8 = tid & 15; if (tok < ntok) {
                *(LAS f32x4*)(q_s + tok * 128 + c8 * 8) = (f32x4){bflo(pq.x), bfhi(pq.x), bflo(pq.y), bfhi(pq.y)};
                *(LAS f32x4*)(q_s + tok * 128 + c8 * 8 + 4) = (f32x4){bflo(pq.z), bfhi(pq.z), bflo(pq.w), bfhi(pq.w)}; } }
            if (tid < 128) { const int tok = tid >> 2, c8 = tid & 3; if (tok < ntok) {
                *(LAS f32x4*)(v_s + tok * 32 + c8 * 8) = (f32x4){bflo(pv.x), bfhi(pv.x), bflo(pv.y), bfhi(pv.y)};
                *(LAS f32x4*)(v_s + tok * 32 + c8 * 8 + 4) = (f32x4){bflo(pv.z), bfhi(pv.z), bflo(pv.w), bfhi(pv.w)}; } }
            __syncthreads();
            if (bt + 1 < nb) loadb(bt + 1);
            for (int t = 0; t < ntok; ++t) {
                const f32x4 fa = *(const LAS f32x4*)(f_s + t * 128 + kg * 8), fb = *(const LAS f32x4*)(f_s + t * 128 + kg * 8 + 4);
                const f32x4 qa = *(const LAS f32x4*)(q_s + t * 128 + kg * 8), qb = *(const LAS f32x4*)(q_s + t * 128 + kg * 8 + 4);
                const float vv = v_s[t * 32 + vloc];
                float pa = 0.f, pb = 0.f;
#pragma unroll
                for (int i = 0; i < 4; ++i) { S[i] = vv + fa[i] * (S[i] - vv); pa += S[i] * qa[i]; S[4 + i] = vv + fb[i] * (S[4 + i] - vv); pb += S[4 + i] * qb[i]; }
                op_s[(t * 16 + kg) * 32 + vloc] = pa + pb;
            }
            __syncthreads();
#pragma unroll
            for (int r = 0; r < 2; ++r) { const int idx = tid + 512 * r, tok = idx >> 5, vl = idx & 31;
                if (tok < ntok) { float s = 0.f;
#pragma unroll
                    for (int gq = 0; gq < 16; ++gq) s += op_s[(tok * 16 + gq) * 32 + vl];
                    O[(size_t)(row0 + t0 + tok) * 1024 + col0 + qv * 32 + vl] = s; } }
        }
#pragma unroll
        for (int i = 0; i < 8; ++i) So[(size_t)(kg * 8 + i) * 128 + vc] = S[i];
    }
}
__device__ __forceinline__ void hgrn_post(const Params& p, int j) {
    const float* O = (const float*)(p.ws + WS_B3); const bf16_t* Gt = (const bf16_t*)(p.ws + WS_B1) + (size_t)2 * NT * 1024; bf16_t* A2 = (bf16_t*)(p.ws + WS_B3 + 66 * MiB);
    const int tid_ = tidx(), lane = tid_ & 63, gw = blockIdx.x * 8 + (tid_ >> 6), nw = gridDim.x * 8;
    const float* ng = p.in[15] + j * 128 + (lane & 7) * 16;
    for (int m = gw; m < NT; m += nw) {
        const size_t off = (size_t)m * 1024 + lane * 16;
        f32x4 o[4]; float ss = 0.f;
#pragma unroll
        for (int i = 0; i < 4; ++i) { o[i] = ld4(O + off + 4 * i); ss += o[i][0] * o[i][0] + o[i][1] * o[i][1] + o[i][2] * o[i][2] + o[i][3] * o[i][3]; }
        ss = red8(ss);
        const float rstd = rsqrtf(ss * (1.0f / 128.0f) + NORM_EPS);
        const u32x4 g0 = *(const u32x4*)(Gt + off), g1 = *(const u32x4*)(Gt + off + 8);
        const float gf[16] = {bflo(g0.x), bfhi(g0.x), bflo(g0.y), bfhi(g0.y), bflo(g0.z), bfhi(g0.z), bflo(g0.w), bfhi(g0.w), bflo(g1.x), bfhi(g1.x), bflo(g1.y), bfhi(g1.y), bflo(g1.z), bfhi(g1.z), bflo(g1.w), bfhi(g1.w)};
        float r[16];
#pragma unroll
        for (int i = 0; i < 4; ++i) { const f32x4 n4 = ld4(ng + 4 * i);
#pragma unroll
            for (int q = 0; q < 4; ++q) r[4 * i + q] = o[i][q] * rstd * n4[q] * gf[4 * i + q]; }
        u32x4 w0, w1; w0.x = cvt_pk_bf16(r[0], r[1]); w0.y = cvt_pk_bf16(r[2], r[3]); w0.z = cvt_pk_bf16(r[4], r[5]); w0.w = cvt_pk_bf16(r[6], r[7]);
        w1.x = cvt_pk_bf16(r[8], r[9]); w1.y = cvt_pk_bf16(r[10], r[11]); w1.z = cvt_pk_bf16(r[12], r[13]); w1.w = cvt_pk_bf16(r[14], r[15]);
        *(u32x4*)(A2 + off) = w0; *(u32x4*)(A2 + off + 8) = w1;
    }
}

__device__ __forceinline__ void rwkv_scan(const Params& p, LAS unsigned char* lds) {
    const bf16_t* RKV = (const bf16_t*)(p.ws + WS_B1); const float* DEC = (const float*)(p.ws + WS_B2); const bf16_t* AA = (const bf16_t*)(p.ws + WS_B3);
    float* O = (float*)(p.ws + WS_B0); float* RHO = (float*)(p.ws + WS_B4);
    LAS float* w_s = (LAS float*)lds; LAS float* n_s = w_s + 2048; LAS float* ka_s = n_s + 2048; LAS float* kp_s = ka_s + 2048; LAS float* r_s = kp_s + 2048; LAS float* v_s = r_s + 2048; LAS float* o_s = v_s + 1024;
    const int tid = tidx(), w = tid >> 6, l = tid & 63;
    const int stok = tid >> 4, sc = tid & 15;
    const int g = l >> 4, c = l & 15, vr0 = 8 * w + 2 * g;
    for (int task = blockIdx.x; task < 256 + 4096; task += gridDim.x) {
        int b, h, half, T, row0; const float* S0; float* So;
        if (task < 256) { b = task >> 5; h = (task >> 1) & 15; half = task & 1; T = 2048; row0 = b * 2048; S0 = nullptr; So = p.out + O_WKVP + ((size_t)b * 16 + h) * 4096; }
        else { const int u = task - 256; b = u >> 5; h = (u >> 1) & 15; half = u & 1; T = 4; row0 = NP + b * 4; S0 = p.in[3] + ((size_t)b * 16 + h) * 4096; So = p.out + O_WKVS + ((size_t)b * 16 + h) * 4096; }
        const int ch = h * 64 + 4 * sc;
        const f32x4 kk4 = ld4(p.in[27] + ch), ka4 = ld4(p.in[28] + ch), rk4 = ld4(p.in[29] + ch);
        f32x4 S0r = (f32x4){0.f, 0.f, 0.f, 0.f}, S1r = S0r;
        if (w < 4 && S0) { S0r = ld4(S0 + (size_t)(half * 32 + vr0) * 64 + 4 * c); S1r = ld4(S0 + (size_t)(half * 32 + vr0 + 1) * 64 + 4 * c); }
        const int nb = (T + 31) >> 5;
        u32x2 pr, pk, pv, pa; f32x4 pd;
        auto loadb = [&](int bt) {
            const int t0 = bt * 32, ntok = min(32, T - t0);
            if (stok < ntok) { const size_t m = (size_t)(row0 + t0 + stok);
                pr = *(const u32x2*)(RKV + m * 3072 + ch); pk = *(const u32x2*)(RKV + m * 3072 + 1024 + ch); pv = *(const u32x2*)(RKV + m * 3072 + 2048 + ch);
                pd = ld4(DEC + m * 1024 + ch); pa = *(const u32x2*)(AA + m * 1024 + ch); }
        };
        loadb(0);
        for (int bt = 0; bt < nb; ++bt) {
            const int t0 = bt * 32, ntok = min(32, T - t0);
            __syncthreads();
            if (stok < ntok) {
                const f32x4 kf = (f32x4){bflo(pk.x), bfhi(pk.x), bflo(pk.y), bfhi(pk.y)}, rf = (f32x4){bflo(pr.x), bfhi(pr.x), bflo(pr.y), bfhi(pr.y)};
                const f32x4 vf = (f32x4){bflo(pv.x), bfhi(pv.x), bflo(pv.y), bfhi(pv.y)}, af = (f32x4){bflo(pa.x), bfhi(pa.x), bflo(pa.y), bfhi(pa.y)};
                f32x4 kr = kf * kk4; float ss = kr[0] * kr[0] + kr[1] * kr[1] + kr[2] * kr[2] + kr[3] * kr[3];
                ss = red16(ss);
                const float inv = rsqrtf(fmaxf(ss, 1e-24f));
                const f32x4 kn = kr * inv;
                const f32x4 kp = kf * (1.0f + (af - 1.0f) * ka4);
                float rho = rf[0] * kp[0] * rk4[0] + rf[1] * kp[1] * rk4[1] + rf[2] * kp[2] * rk4[2] + rf[3] * kp[3] * rk4[3];
                rho = red16(rho);
                if (half == 0 && sc == 0) RHO[(size_t)(row0 + t0 + stok) * 16 + h] = rho;
                *(LAS f32x4*)(w_s + stok * 64 + 4 * sc) = pd; *(LAS f32x4*)(n_s + stok * 64 + 4 * sc) = -kn; *(LAS f32x4*)(ka_s + stok * 64 + 4 * sc) = kn * af;
                *(LAS f32x4*)(kp_s + stok * 64 + 4 * sc) = kp; *(LAS f32x4*)(r_s + stok * 64 + 4 * sc) = rf;
                if ((sc >> 3) == half) *(LAS f32x4*)(v_s + stok * 32 + (sc & 7) * 4) = vf;
            }
            __syncthreads();
            if (bt + 1 < nb) loadb(bt + 1);
            if (w < 4) {
                for (int t = 0; t < ntok; ++t) {
                    const f32x4 w4 = *(const LAS f32x4*)(w_s + t * 64 + 4 * c), n4 = *(const LAS f32x4*)(n_s + t * 64 + 4 * c), k4 = *(const LAS f32x4*)(ka_s + t * 64 + 4 * c);
                    const f32x4 p4 = *(const LAS f32x4*)(kp_s + t * 64 + 4 * c), r4 = *(const LAS f32x4*)(r_s + t * 64 + 4 * c);
                    const f32x2 vv = *(const LAS f32x2*)(v_s + t * 32 + vr0);
                    float sa0 = S0r[0] * n4[0] + S0r[1] * n4[1] + S0r[2] * n4[2] + S0r[3] * n4[3];
                    float sa1 = S1r[0] * n4[0] + S1r[1] * n4[1] + S1r[2] * n4[2] + S1r[3] * n4[3];
                    sa0 = red16(sa0); sa1 = red16(sa1);
                    S0r = S0r * w4 + sa0 * k4 + vv.x * p4;
                    S1r = S1r * w4 + sa1 * k4 + vv.y * p4;
                    float o0 = S0r[0] * r4[0] + S0r[1] * r4[1] + S0r[2] * r4[2] + S0r[3] * r4[3];
                    float o1 = S1r[0] * r4[0] + S1r[1] * r4[1] + S1r[2] * r4[2] + S1r[3] * r4[3];
                    o0 = red16(o0); o1 = red16(o1);
                    if (c == 0) *(LAS f32x2*)(o_s + t * 32 + vr0) = (f32x2){o0, o1};
                }
            }
            __syncthreads();
#pragma unroll
            for (int r = 0; r < 2; ++r) { const int idx = tid + 512 * r, tok = idx >> 5, vl = idx & 31;
                if (tok < ntok) O[(size_t)(row0 + t0 + tok) * 1024 + h * 64 + half * 32 + vl] = o_s[tok * 32 + vl]; }
        }
        if (w < 4) { *(f32x4*)(So + (size_t)(half * 32 + vr0) * 64 + 4 * c) = S0r; *(f32x4*)(So + (size_t)(half * 32 + vr0 + 1) * 64 + 4 * c) = S1r; }
    }
}
__device__ __forceinline__ void rwkv_post(const Params& p) {
    const float* O = (const float*)(p.ws + WS_B0); const bf16_t* RKV = (const bf16_t*)(p.ws + WS_B1); const bf16_t* GATE = (const bf16_t*)(p.ws + WS_B3) + (size_t)NT * 1024;
    const float* RHO = (const float*)(p.ws + WS_B4); bf16_t* A2 = (bf16_t*)(p.ws + WS_B2);
    const int tid_ = tidx(), lane = tid_ & 63, gw = blockIdx.x * 8 + (tid_ >> 6), nw = gridDim.x * 8;
    for (int m = gw; m < NT; m += nw) {
        const size_t off = (size_t)m * 1024 + lane * 16;
        f32x4 o[4]; float s = 0.f;
#pragma unroll
        for (int i = 0; i < 4; ++i) { o[i] = ld4(O + off + 4 * i); s += o[i][0] + o[i][1] + o[i][2] + o[i][3]; }
        s = red4(s); const float mean = s * (1.0f / 64.0f); float q = 0.f;
#pragma unroll
        for (int i = 0; i < 4; ++i) { o[i] = o[i] - mean; q += o[i][0] * o[i][0] + o[i][1] * o[i][1] + o[i][2] * o[i][2] + o[i][3] * o[i][3]; }
        q = red4(q); const float rstd = rsqrtf(q * (1.0f / 64.0f) + 64e-5f);
        const float rho = RHO[(size_t)m * 16 + (lane >> 2)];
        const u32x4 v0 = *(const u32x4*)(RKV + (size_t)m * 3072 + 2048 + lane * 16), v1 = *(const u32x4*)(RKV + (size_t)m * 3072 + 2048 + lane * 16 + 8);
        const u32x4 g0 = *(const u32x4*)(GATE + off), g1 = *(const u32x4*)(GATE + off + 8);
        const float vf[16] = {bflo(v0.x), bfhi(v0.x), bflo(v0.y), bfhi(v0.y), bflo(v0.z), bfhi(v0.z), bflo(v0.w), bfhi(v0.w), bflo(v1.x), bfhi(v1.x), bflo(v1.y), bfhi(v1.y), bflo(v1.z), bfhi(v1.z), bflo(v1.w), bfhi(v1.w)};
        const float gf[16] = {bflo(g0.x), bfhi(g0.x), bflo(g0.y), bfhi(g0.y), bflo(g0.z), bfhi(g0.z), bflo(g0.w), bfhi(g0.w), bflo(g1.x), bfhi(g1.x), bflo(g1.y), bfhi(g1.y), bflo(g1.z), bfhi(g1.z), bflo(g1.w), bfhi(g1.w)};
        float r[16];
#pragma unroll
        for (int i = 0; i < 4; ++i) { const f32x4 lw = ld4(p.in[30] + lane * 16 + 4 * i), lb = ld4(p.in[31] + lane * 16 + 4 * i);
#pragma unroll
            for (int qq = 0; qq < 4; ++qq) r[4 * i + qq] = (o[i][qq] * rstd * lw[qq] + lb[qq] + rho * vf[4 * i + qq]) * gf[4 * i + qq]; }
        u32x4 w0, w1; w0.x = cvt_pk_bf16(r[0], r[1]); w0.y = cvt_pk_bf16(r[2], r[3]); w0.z = cvt_pk_bf16(r[4], r[5]); w0.w = cvt_pk_bf16(r[6], r[7]);
        w1.x = cvt_pk_bf16(r[8], r[9]); w1.y = cvt_pk_bf16(r[10], r[11]); w1.z = cvt_pk_bf16(r[12], r[13]); w1.w = cvt_pk_bf16(r[14], r[15]);
        *(u32x4*)(A2 + off) = w0; *(u32x4*)(A2 + off + 8) = w1;
    }
}

__device__ __forceinline__ void mamba_scan(const Params& p, LAS unsigned char* lds) {
    const bf16_t* XBC = (const bf16_t*)(p.ws + WS_B1); const float* DT = (const float*)(p.ws + WS_B4); bf16_t* Y = (bf16_t*)(p.ws + WS_B3);
    const int tid = tidx(), w = tid >> 6, l = tid & 63, G = gridDim.x;
    for (size_t i = (size_t)blockIdx.x * 512 + tid; i < (size_t)136 * 3 * 384; i += (size_t)G * 512) {
        const int c8 = (int)(i % 384), rr = (int)((i / 384) % 3), sq = (int)(i / (384 * 3));
        const size_t m = sq < 8 ? (size_t)sq * 2048 + 2045 + rr : (size_t)NP + (size_t)(sq - 8) * 4 + 1 + rr;
        float* dst = sq < 8 ? p.out + O_CVP + ((size_t)sq * 3 + rr) * 3072 + c8 * 8 : p.out + O_CVS + ((size_t)(sq - 8) * 3 + rr) * 3072 + c8 * 8;
        const u32x4 x = *(const u32x4*)(XBC + m * 3072 + c8 * 8);
        *(f32x4*)dst = (f32x4){bflo(x.x), bfhi(x.x), bflo(x.y), bfhi(x.y)}; *(f32x4*)(dst + 4) = (f32x4){bflo(x.z), bfhi(x.z), bflo(x.w), bfhi(x.w)};
    }
    LAS float* raw_s = (LAS float*)lds;
    LAS float* xd_s = raw_s + 19 * 320;
    LAS float* x_s = xd_s + 16 * 64;
    LAS float* B_s = x_s + 16 * 64;
    LAS float* C_s = B_s + 16 * 128;
    LAS float* dt_s = C_s + 16 * 128;
    LAS float* yp_s = dt_s + 32;
    const int pl = l >> 2, nlo = l & 3, p0 = 4 * pl, n0 = 16 * w + 4 * nlo;
    for (int task = blockIdx.x; task < 256 + 4096; task += G) {
        int b, hd, T, row0; const float* S0; float* So; const float* cv0;
        if (task < 256) { b = task >> 5; hd = task & 31; T = 2048; row0 = b * 2048; S0 = nullptr; cv0 = nullptr; So = p.out + O_SSMP + ((size_t)b * 32 + hd) * 8192; }
        else { const int u = task - 256; b = u >> 5; hd = u & 31; T = 4; row0 = NP + b * 4; S0 = p.in[5] + ((size_t)b * 32 + hd) * 8192; cv0 = p.in[6] + (size_t)b * 3 * 3072; So = p.out + O_SSMS + ((size_t)b * 32 + hd) * 8192; }
        const int grp = hd >> 3;
        const float Aneg = -__expf(p.in[37][hd]), Dsk = p.in[38][hd];
        int gch = 0; float cw0 = 0.f, cw1 = 0.f, cw2 = 0.f, cw3 = 0.f, cbias = 0.f;
        if (tid < 320) { gch = tid < 64 ? hd * 64 + tid : (tid < 192 ? 2048 + grp * 128 + (tid - 64) : 2560 + grp * 128 + (tid - 192));
            cw0 = p.in[34][gch]; cw1 = p.in[34][3072 + gch]; cw2 = p.in[34][2 * 3072 + gch]; cw3 = p.in[34][3 * 3072 + gch]; cbias = p.in[35][gch]; }
        f32x4 hs[4];
#pragma unroll
        for (int jj = 0; jj < 4; ++jj) hs[jj] = S0 ? ld4(S0 + (size_t)(p0 + jj) * 128 + n0) : (f32x4){0.f, 0.f, 0.f, 0.f};
        const int nb = (T + 15) >> 4;
        u32x4 pre[2]; float pdt = 0.f;
        auto loadb = [&](int bt) {
            const int t0 = bt * 16, ntok = min(16, T - t0);
#pragma unroll
            for (int r = 0; r < 2; ++r) { const int gi = tid + 512 * r; if (gi < 760) { const int rr = gi / 40, c8 = gi % 40, tt = t0 - 3 + rr, lc = c8 * 8;
                    const int gc = lc < 64 ? hd * 64 + lc : (lc < 192 ? 2048 + grp * 128 + (lc - 64) : 2560 + grp * 128 + (lc - 192));
                    if (tt >= 0 && tt < t0 + ntok) pre[r] = *(const u32x4*)(XBC + (size_t)(row0 + tt) * 3072 + gc); } }
            if (tid < ntok) pdt = DT[(size_t)(row0 + t0 + tid) * 32 + hd];
        };
        loadb(0);
        for (int bt = 0; bt < nb; ++bt) {
            const int t0 = bt * 16, ntok = min(16, T - t0);
            __syncthreads();
#pragma unroll
            for (int r = 0; r < 2; ++r) { const int gi = tid + 512 * r; if (gi < 760) { const int rr = gi / 40, c8 = gi % 40, tt = t0 - 3 + rr, lc = c8 * 8;
                    f32x4 a = (f32x4){0.f, 0.f, 0.f, 0.f}, c = a;
                    if (tt >= 0) { if (tt < t0 + ntok) { const u32x4 x = pre[r]; a = (f32x4){bflo(x.x), bfhi(x.x), bflo(x.y), bfhi(x.y)}; c = (f32x4){bflo(x.z), bfhi(x.z), bflo(x.w), bfhi(x.w)}; } }
                    else if (cv0) { const int gc = lc < 64 ? hd * 64 + lc : (lc < 192 ? 2048 + grp * 128 + (lc - 64) : 2560 + grp * 128 + (lc - 192));
                        a = ld4(cv0 + (size_t)(3 + tt) * 3072 + gc); c = ld4(cv0 + (size_t)(3 + tt) * 3072 + gc + 4); }
                    *(LAS f32x4*)(raw_s + rr * 320 + lc) = a; *(LAS f32x4*)(raw_s + rr * 320 + lc + 4) = c; } }
            if (tid < ntok) { dt_s[tid] = pdt; dt_s[16 + tid] = __expf(pdt * Aneg); }
            __syncthreads();
            if (bt + 1 < nb) loadb(bt + 1);
            if (tid < 320) {
                float r0 = raw_s[0 * 320 + tid], r1 = raw_s[1 * 320 + tid], r2 = raw_s[2 * 320 + tid];
                for (int t = 0; t < ntok; ++t) {
                    const float r3 = raw_s[(t + 3) * 320 + tid];
                    const float cv = cbias + r0 * cw0 + r1 * cw1 + r2 * cw2 + r3 * cw3;
                    const float val = siluf_(cv);
                    if (tid < 64) { x_s[t * 64 + tid] = val; xd_s[t * 64 + tid] = val * dt_s[t]; }
                    else if (tid < 192) B_s[t * 128 + tid - 64] = val; else C_s[t * 128 + tid - 192] = val;
                    r0 = r1; r1 = r2; r2 = r3;
                }
            }
            __syncthreads();
            for (int t = 0; t < ntok; ++t) {
                const f32x4 B4 = *(const LAS f32x4*)(B_s + t * 128 + n0), C4 = *(const LAS f32x4*)(C_s + t * 128 + n0), xd = *(const LAS f32x4*)(xd_s + t * 64 + p0);
                const float dA = dt_s[16 + t];
                f32x4 y;
#pragma unroll
                for (int jj = 0; jj < 4; ++jj) { hs[jj] = hs[jj] * dA + xd[jj] * B4; const f32x4 pr = hs[jj] * C4; y[jj] = red4((pr[0] + pr[1]) + (pr[2] + pr[3])); }
                if (nlo == 0) *(LAS f32x4*)(yp_s + (t * 8 + w) * 64 + p0) = y;
            }
            __syncthreads();
#pragma unroll
            for (int r = 0; r < 2; ++r) { const int idx = tid + 512 * r, tok = idx >> 6, pp = idx & 63;
                if (tok < ntok) { float s = Dsk * x_s[tok * 64 + pp];
#pragma unroll
                    for (int ww = 0; ww < 8; ++ww) s += yp_s[(tok * 8 + ww) * 64 + pp];
                    Y[(size_t)(row0 + t0 + tok) * 2048 + hd * 64 + pp] = (bf16_t)(cvt_pk_bf16(s, 0.f) & 0xffffu); } }
        }
#pragma unroll
        for (int jj = 0; jj < 4; ++jj) *(f32x4*)(So + (size_t)(p0 + jj) * 128 + n0) = hs[jj];
    }
}
__device__ __forceinline__ void mamba_post(const Params& p) {
    const bf16_t* Y = (const bf16_t*)(p.ws + WS_B3); const bf16_t* Z = (const bf16_t*)(p.ws + WS_B2); bf16_t* A2 = (bf16_t*)(p.ws + WS_B1);
    const int tid_ = tidx(), lane = tid_ & 63, gw = blockIdx.x * 8 + (tid_ >> 6), nw = gridDim.x * 8;
    for (int m = gw; m < NT; m += nw) {
        const size_t off = (size_t)m * 2048 + lane * 32;
        float v[32]; float ss = 0.f;
#pragma unroll
        for (int i = 0; i < 4; ++i) { const u32x4 y = *(const u32x4*)(Y + off + 8 * i), z = *(const u32x4*)(Z + off + 8 * i);
            v[8 * i + 0] = bflo(y.x) * bflo(z.x); v[8 * i + 1] = bfhi(y.x) * bfhi(z.x); v[8 * i + 2] = bflo(y.y) * bflo(z.y); v[8 * i + 3] = bfhi(y.y) * bfhi(z.y);
            v[8 * i + 4] = bflo(y.z) * bflo(z.z); v[8 * i + 5] = bfhi(y.z) * bfhi(z.z); v[8 * i + 6] = bflo(y.w) * bflo(z.w); v[8 * i + 7] = bfhi(y.w) * bfhi(z.w); }
#pragma unroll
        for (int i = 0; i < 32; ++i) ss += v[i] * v[i];
        ss = red16(ss);
        const float rstd = rsqrtf(ss * (1.0f / 512.0f) + NORM_EPS);
#pragma unroll
        for (int i = 0; i < 4; ++i) { const f32x4 g0 = ld4(p.in[39] + lane * 32 + 8 * i), g1 = ld4(p.in[39] + lane * 32 + 8 * i + 4); u32x4 o;
            o.x = cvt_pk_bf16(v[8 * i] * rstd * g0[0], v[8 * i + 1] * rstd * g0[1]); o.y = cvt_pk_bf16(v[8 * i + 2] * rstd * g0[2], v[8 * i + 3] * rstd * g0[3]);
            o.z = cvt_pk_bf16(v[8 * i + 4] * rstd * g1[0], v[8 * i + 5] * rstd * g1[1]); o.w = cvt_pk_bf16(v[8 * i + 6] * rstd * g1[2], v[8 * i + 7] * rstd * g1[3]);
            *(u32x4*)(A2 + off + 8 * i) = o; }
    }
}

__global__ void __launch_bounds__(512, 2) mega(Params p_unused) {
    extern __shared__ __attribute__((aligned(16))) unsigned char shm[];
    LAS unsigned char* lds = (LAS unsigned char*)shm;
    cg::grid_group grid = cg::this_grid();
    volatile LAS unsigned* xst = (volatile LAS unsigned*)(lds + LDS_BYTES - 16);
    if (threadIdx.x < 4) xst[threadIdx.x] = 0u;
    __syncthreads();
    const XcdBarrier xbar = xcd_barrier_post((unsigned*)getp().ws, xst);
#define SYNC() xcd_barrier(xbar)
#define WSP (getp().ws)
#define WBP ((bf16_t*)(getp().ws + WS_WB))
    convert_weights(getp(), (LAS float*)lds);
    { const Params& p = getp(); norm_phase(p, 0, p.in[7], true); }
    grid.sync();
#pragma unroll 1
    for (int layer = 0; layer < 4; ++layer) {
        const int kind = layer % 3, j = layer / 3;
        const bf16_t* resA; const bf16_t* resB; int resK;
        if (kind == 0) {
            { const Params& p = getp(); unsigned char* B1 = p.ws + WS_B1;
              EpiArgs ea{B1, p.ws + WS_B2, B1 + (size_t)NT * 2048, B1 + (size_t)NT * 4096, p.in[14], nullptr, j};
              run_gemm<EP_HG_IN>(lds, (const bf16_t*)(p.ws + WS_B0), (const bf16_t*)(p.ws + WS_WB) + W_HGIN + j * W_HGIN_SZ, 1024, 16, false, ea); }
            SYNC();
            hgrn_scan(getp(), j, lds);
            SYNC();
            hgrn_post(getp(), j);
            resA = (const bf16_t*)(WSP + WS_B3 + 66 * MiB); resB = WBP + W_HGOUT + j * W_HGOUT_SZ; resK = 1024;
        } else if (kind == 1) {
            { const Params& p = getp();
              EpiArgs ea{p.ws + WS_B1, p.ws + WS_B3 + (size_t)NT * 4096, nullptr, nullptr, nullptr, nullptr, 0};
              run_gemm<EP_RW_IN>(lds, (const bf16_t*)(p.ws + WS_B0), (const bf16_t*)(p.ws + WS_WB) + W_RWIN, 2048, 13, false, ea); }
            SYNC();
            { const Params& p = getp(); unsigned char* B3 = p.ws + WS_B3;
              EpiArgs e2{p.ws + WS_B2, B3, B3 + (size_t)NT * 2048, nullptr, p.in[19], p.in[22], 0};
              run_gemm<EP_RW_L2>(lds, (const bf16_t*)(B3 + (size_t)NT * 4096), (const bf16_t*)(p.ws + WS_WB) + W_RWL2, 256, 12, false, e2); }
            SYNC();
            rwkv_scan(getp(), lds);
            SYNC();
            rwkv_post(getp());
            resA = (const bf16_t*)(WSP + WS_B2); resB = WBP + W_RWOUT; resK = 1024;
        } else {
            { const Params& p = getp();
              EpiArgs ea{p.ws + WS_B2, p.ws + WS_B1, p.ws + WS_B4, nullptr, p.in[36], nullptr, 0};
              run_gemm<EP_MB_IN>(lds, (const bf16_t*)(p.ws + WS_B0), (const bf16_t*)(p.ws + WS_WB) + W_MBIN, 1024, 21, false, ea); }
            SYNC();
            mamba_scan(getp(), lds);
            SYNC();
            mamba_post(getp());
            resA = (const bf16_t*)(WSP + WS_B1); resB = WBP + W_MBOUT; resK = 2048;
        }
        SYNC();
        { EpiArgs er{getp().out, nullptr, nullptr, nullptr, nullptr, nullptr, 0};
          run_gemm<EP_RES>(lds, resA, resB, resK, 4, true, er); }
        SYNC();
        { const Params& p = getp(); norm_phase(p, 0, p.in[8] + layer * 1024, false); }
        SYNC();
        { const Params& p = getp(); EpiArgs ea{p.ws + WS_B1, nullptr, nullptr, nullptr, nullptr, nullptr, 0};
          run_gemm<EP_FFN>(lds, (const bf16_t*)(p.ws + WS_B0), (const bf16_t*)(p.ws + WS_WB) + W_GU + layer * W_GU_SZ, 1024, 22, false, ea); }
        SYNC();
        { const Params& p = getp(); EpiArgs er{p.out, nullptr, nullptr, nullptr, nullptr, nullptr, 0};
          run_gemm<EP_RES>(lds, (const bf16_t*)(p.ws + WS_B1), (const bf16_t*)(p.ws + WS_WB) + W_D + layer * W_D_SZ, 2816, 4, true, er); }
        SYNC();
        { const Params& p = getp();
          if (layer < 3) norm_phase(p, ((layer + 1) % 3 == 1) ? 1 : 0, p.in[7] + (layer + 1) * 1024, false);
          else norm_phase(p, 2, p.in[9], false); }
        if (layer < 3) SYNC();
    }
}

extern "C" void kernel_launch(void* const* d_in, const int* in_sizes, int n_in, void* d_out, int out_size, void* d_ws, size_t ws_size, hipStream_t stream) {
    static int grid_blocks = 0;
    if (!grid_blocks) {
        int dev = 0, cus = 0, per_cu = 0;
        hipGetDevice(&dev);
        hipDeviceGetAttribute(&cus, hipDeviceAttributeMultiprocessorCount, dev);
        hipFuncSetAttribute((const void*)mega, hipFuncAttributeMaxDynamicSharedMemorySize, LDS_BYTES);
        hipOccupancyMaxActiveBlocksPerMultiprocessor(&per_cu, (const void*)mega, 512, LDS_BYTES);
        if (per_cu < 1) per_cu = 1;
        grid_blocks = cus * per_cu;
        if (ws_size < WS_END) fprintf(stderr, "kernel_launch: workspace too small: %zu < %zu\n", ws_size, (size_t)WS_END);
    }
    (void)hipMemsetAsync(d_ws, 0, XCD_BAR_WORDS * 4, stream);
    Params p{};
    for (int i = 0; i < 41; ++i) p.in[i] = (const float*)d_in[i];
    p.out = (float*)d_out; p.ws = (unsigned char*)d_ws;
    void* args[] = {&p};
    hipError_t e = hipLaunchCooperativeKernel((const void*)mega, dim3(grid_blocks), dim3(512), args, LDS_BYTES, stream);
    if (e != hipSuccess) fprintf(stderr, "cooperative launch failed: %s (grid %d)\n", hipGetErrorString(e), grid_blocks);
}
```
